# Optimizing an MI355X kernel written in HIP

```python
import math
import jax, jax.numpy as jnp
from jax import lax
import numpy as np

D_MODEL = 1024
BATCH = 8
SEQ = 2048
DEPTH = 2

BRANCH_WIDTH = D_MODEL // 2
N_BRANCHES = 4
CHUNK = 64
CONV_WIDTH = 4
NORM_EPS = 1e-6

HGRN_HEADS = 4
HGRN_EXPAND = BRANCH_WIDTH // HGRN_HEADS
HGRN_FDIM = HGRN_HEADS * HGRN_EXPAND
HGRN_VDIM = BRANCH_WIDTH
HGRN_VHEAD = HGRN_VDIM // HGRN_HEADS
SSD_DINNER = BRANCH_WIDTH
SSD_HEADDIM = 64
SSD_HEADS = SSD_DINNER // SSD_HEADDIM
SSD_GROUPS = 2
SSD_HPG = SSD_HEADS // SSD_GROUPS
SSD_STATE = 64
SSD_CONV_DIM = SSD_DINNER + 2 * SSD_GROUPS * SSD_STATE
GLA_HEADS = 4
GLA_KDIM = BRANCH_WIDTH // 2
GLA_VDIM = BRANCH_WIDTH
GLA_HEAD_K = GLA_KDIM // GLA_HEADS
GLA_HEAD_V = GLA_VDIM // GLA_HEADS
GLA_GATE_RANK = 16
GLA_GATE_NORMALIZER = 16.0
LRU_WIDTH = BRANCH_WIDTH
LRU_BLOCKS = 8
LRU_BLOCK = LRU_WIDTH // LRU_BLOCKS
LRU_C = 8.0
D_FF = ((8 * D_MODEL // 3 + 255) // 256) * 256

IN_SPLITS = (
    HGRN_FDIM, HGRN_FDIM, HGRN_VDIM, HGRN_VDIM,
    SSD_DINNER, SSD_CONV_DIM, SSD_HEADS,
    GLA_KDIM, GLA_KDIM, GLA_VDIM, GLA_VDIM, GLA_GATE_RANK,
    LRU_WIDTH, LRU_WIDTH,
    N_BRANCHES * D_MODEL,
)
D_IN = sum(IN_SPLITS)

kernel_name = "hybrid_hgrn2_ssd_gla_rglru_block"

F32 = jnp.float32


def rmsnorm(x, w):
    xf = x.astype(F32)
    y = xf * lax.rsqrt(jnp.mean(xf * xf, axis=-1, keepdims=True) + NORM_EPS)
    return (y * w.astype(F32)).astype(x.dtype)


def causal_dwconv(x, w, b):
    c = x.shape[-1]
    y = lax.conv_general_dilated(
        x, w[:, None, :].astype(x.dtype), window_strides=(1,),
        padding=[(w.shape[0] - 1, 0)], dimension_numbers=("NWC", "WIO", "NWC"),
        feature_group_count=c)
    return y + b.astype(x.dtype)


def chunk_gated_linear_attn(q, k, v, log_f):
    bsz, seqlen, nh, dk = q.shape
    dv = v.shape[-1]
    n = seqlen // CHUNK

    def to_chunks(t):
        return jnp.moveaxis(t.astype(F32).reshape(bsz, n, CHUNK, nh, t.shape[-1]), 1, 0)

    qc, kc, vc, gc = to_chunks(q), to_chunks(k), to_chunks(v), to_chunks(log_f)
    causal = jnp.tril(jnp.ones((CHUNK, CHUNK), bool))

    def step(state, inp):
        qi, ki, vi, gi = inp
        bcum = jnp.cumsum(gi, axis=1)
        rel = bcum[:, :, None] - bcum[:, None, :]
        rel = jnp.where(causal[None, :, :, None, None], rel, -jnp.inf)
        scores = jnp.einsum('bihd,bjhd,bijhd->bhij', qi, ki, jnp.exp(rel))
        o_intra = jnp.einsum('bhij,bjhv->bihv', scores, vi)
        o_inter = jnp.einsum('bihd,bhdv->bihv', qi * jnp.exp(bcum), state)
        b_last = bcum[:, -1:]
        k_dec = ki * jnp.exp(b_last - bcum)
        new_state = state * jnp.exp(b_last[:, 0])[..., None] + jnp.einsum('bjhd,bjhv->bhdv', k_dec, vi)
        return new_state, o_intra + o_inter

    s0 = jnp.zeros((bsz, nh, dk, dv), F32)
    _, o = lax.scan(step, s0, (qc, kc, vc, gc))
    return jnp.moveaxis(o, 0, 1).reshape(bsz, seqlen, nh, dv)


def hgrn2_branch(q, f_pre, i, g, lb, norm_w):
    bsz, seqlen, _ = q.shape
    lbf = lb.astype(F32)
    log_f = jnp.logaddexp(jnp.log(lbf), jnp.log1p(-lbf) + jax.nn.log_sigmoid(f_pre.astype(F32)))
    key = -jnp.expm1(log_f)
    qf = jax.nn.silu(q.astype(F32))
    hk = lambda t: t.reshape(bsz, seqlen, HGRN_HEADS, HGRN_EXPAND)
    hv = lambda t: t.reshape(bsz, seqlen, HGRN_HEADS, HGRN_VHEAD)
    o = chunk_gated_linear_attn(hk(qf), hk(key), hv(i.astype(F32)), hk(log_f))
    o = rmsnorm(o, norm_w) * jax.nn.silu(hv(g.astype(F32)))
    return o.reshape(bsz, seqlen, HGRN_VDIM)


def gla_branch(q, k, v, g, gate_lr, gate_w, gate_b, norm_w):
    bsz, seqlen, _ = q.shape
    log_a = jax.nn.log_sigmoid(gate_lr.astype(F32) @ gate_w.astype(F32) + gate_b.astype(F32)) / GLA_GATE_NORMALIZER
    hk = lambda t: t.astype(F32).reshape(bsz, seqlen, GLA_HEADS, GLA_HEAD_K)
    hv = lambda t: t.astype(F32).reshape(bsz, seqlen, GLA_HEADS, GLA_HEAD_V)
    o = chunk_gated_linear_attn(hk(q) * (GLA_HEAD_K ** -0.5), hk(k), hv(v), hk(log_a))
    o = rmsnorm(o, norm_w) * jax.nn.silu(hv(g))
    return o.reshape(bsz, seqlen, GLA_VDIM)


def ssd_branch(z, xbc, dt_raw, conv_w, conv_b, dt_bias, a_log, d_skip, norm_w):
    bsz, seqlen, _ = z.shape
    n = seqlen // CHUNK
    xbc = jax.nn.silu(causal_dwconv(xbc, conv_w, conv_b).astype(F32))
    xs, bm, cm = jnp.split(xbc, [SSD_DINNER, SSD_DINNER + SSD_GROUPS * SSD_STATE], axis=-1)
    dt = jax.nn.softplus(dt_raw.astype(F32) + dt_bias.astype(F32))
    a_neg = -jnp.exp(a_log.astype(F32)).reshape(SSD_GROUPS, SSD_HPG)
    x_c = xs.reshape(bsz, n, CHUNK, SSD_GROUPS, SSD_HPG, SSD_HEADDIM)
    dt_c = dt.reshape(bsz, n, CHUNK, SSD_GROUPS, SSD_HPG)
    b_c = bm.reshape(bsz, n, CHUNK, SSD_GROUPS, SSD_STATE)
    c_c = cm.reshape(bsz, n, CHUNK, SSD_GROUPS, SSD_STATE)
    a_cs = jnp.cumsum(dt_c * a_neg, axis=2)
    xdt = x_c * dt_c[..., None]
    causal = jnp.tril(jnp.ones((CHUNK, CHUNK), bool))
    seg = a_cs[:, :, :, None] - a_cs[:, :, None, :]
    lmat = jnp.exp(jnp.where(causal[None, None, :, :, None, None], seg, -jnp.inf))
    y_diag = jnp.einsum('bcigs,bcjgs,bcijgh,bcjghp->bcighp', c_c, b_c, lmat, xdt)
    decay_states = jnp.exp(a_cs[:, :, -1:] - a_cs)
    states = jnp.einsum('bcjgs,bcjgh,bcjghp->bcghps', b_c, decay_states, xdt)
    cs = jnp.cumsum(a_cs[:, :, -1], axis=1)
    rel = cs[:, :, None] - cs[:, None, :]
    ctril = jnp.tril(jnp.ones((n, n), bool))
    carried = jnp.einsum('bzcgh,bcghps->bzghps',
                         jnp.exp(jnp.where(ctril[None, :, :, None, None], rel, -jnp.inf)), states)
    prev = jnp.concatenate([jnp.zeros_like(carried[:, :1]), carried[:, :-1]], axis=1)
    y_off = jnp.einsum('bcigs,bcghps,bcigh->bcighp', c_c, prev, jnp.exp(a_cs))
    y = y_diag + y_off + x_c * d_skip.astype(F32).reshape(SSD_GROUPS, SSD_HPG)[..., None]
    y = y.reshape(bsz, seqlen, SSD_DINNER) * jax.nn.silu(z.astype(F32))
    yg = y.reshape(bsz, seqlen, SSD_GROUPS, SSD_DINNER // SSD_GROUPS)
    yg = yg * lax.rsqrt(jnp.mean(yg * yg, axis=-1, keepdims=True) + NORM_EPS)
    return yg.reshape(bsz, seqlen, SSD_DINNER) * norm_w.astype(F32)


def rglru_branch(xb, gate, conv_w, conv_b, wa, ba, wx, bx, lam):
    bsz, seqlen, _ = xb.shape
    u = causal_dwconv(xb, conv_w, conv_b).astype(F32)
    ub = u.reshape(bsz, seqlen, LRU_BLOCKS, LRU_BLOCK)
    r = jax.nn.sigmoid(jnp.einsum('blkd,kde->blke', ub, wa.astype(F32)).reshape(bsz, seqlen, LRU_WIDTH) + ba.astype(F32))
    i = jax.nn.sigmoid(jnp.einsum('blkd,kde->blke', ub, wx.astype(F32)).reshape(bsz, seqlen, LRU_WIDTH) + bx.astype(F32))
    log_a = -LRU_C * r * jax.nn.softplus(-lam.astype(F32))
    a = jnp.exp(log_a)
    bterm = jnp.sqrt(-jnp.expm1(2.0 * log_a)) * (i * u)

    def combine(e1, e2):
        a1, b1 = e1
        a2, b2 = e2
        return a1 * a2, a2 * b1 + b2

    _, h = lax.associative_scan(combine, (a, bterm), axis=1)
    return h * jax.nn.gelu(gate.astype(F32), approximate=True)


def setup_inputs(seed: int = 0) -> dict:
    key = jax.random.key(seed)
    ks = jax.random.split(key, 32)
    nrm = lambda k, shape, scale: jax.random.normal(k, shape, F32) * scale
    gain = lambda k, shape: 1.0 + 0.02 * jax.random.normal(k, shape, F32)
    dt = jnp.exp(jax.random.uniform(ks[8], (DEPTH, SSD_HEADS), F32, math.log(1e-3), math.log(1e-1)))
    lam_u = jax.random.uniform(ks[19], (DEPTH, LRU_WIDTH), F32, 0.9, 0.999) ** (1.0 / LRU_C)
    return {
        "x": nrm(ks[0], (BATCH, SEQ, D_MODEL), 1.0),
        "norm_mix_w": gain(ks[1], (DEPTH, D_MODEL)),
        "w_in": nrm(ks[2], (DEPTH, D_MODEL, D_IN), D_MODEL ** -0.5),
        "hgrn_lower_bounds": nrm(ks[3], (DEPTH, HGRN_FDIM), 0.1),
        "hgrn_norm_w": gain(ks[4], (DEPTH, HGRN_VHEAD)),
        "ssd_conv_w": nrm(ks[5], (DEPTH, CONV_WIDTH, SSD_CONV_DIM), CONV_WIDTH ** -0.5),
        "ssd_conv_b": nrm(ks[6], (DEPTH, SSD_CONV_DIM), 0.01),
        "ssd_dt_bias": dt + jnp.log(-jnp.expm1(-dt)),
        "ssd_a_log": jnp.log(jax.random.uniform(ks[9], (DEPTH, SSD_HEADS), F32, 1.0, 16.0)),
        "ssd_d": gain(ks[10], (DEPTH, SSD_HEADS)),
        "ssd_norm_w": gain(ks[11], (DEPTH, SSD_DINNER)),
        "gla_gate_w": nrm(ks[12], (DEPTH, GLA_GATE_RANK, GLA_KDIM), GLA_GATE_RANK ** -0.5),
        "gla_gate_b": nrm(ks[13], (DEPTH, GLA_KDIM), 0.01),
        "gla_norm_w": gain(ks[14], (DEPTH, GLA_HEAD_V)),
        "lru_conv_w": nrm(ks[15], (DEPTH, CONV_WIDTH, LRU_WIDTH), CONV_WIDTH ** -0.5),
        "lru_conv_b": nrm(ks[16], (DEPTH, LRU_WIDTH), 0.01),
        "lru_wa": nrm(ks[17], (DEPTH, LRU_BLOCKS, LRU_BLOCK, LRU_BLOCK), LRU_BLOCK ** -0.5),
        "lru_ba": nrm(ks[18], (DEPTH, LRU_WIDTH), 0.01),
        "lru_wx": nrm(ks[20], (DEPTH, LRU_BLOCKS, LRU_BLOCK, LRU_BLOCK), LRU_BLOCK ** -0.5),
        "lru_bx": nrm(ks[21], (DEPTH, LRU_WIDTH), 0.01),
        "lru_lambda": jnp.log(lam_u) - jnp.log1p(-lam_u),
        "w_branch": nrm(ks[22], (DEPTH, N_BRANCHES, BRANCH_WIDTH, D_MODEL), BRANCH_WIDTH ** -0.5),
        "w_out": nrm(ks[23], (DEPTH, D_MODEL, D_MODEL), D_MODEL ** -0.5),
        "norm_ffn_w": gain(ks[24], (DEPTH, D_MODEL)),
        "w_ffn_in": nrm(ks[25], (DEPTH, D_MODEL, 2 * D_FF), D_MODEL ** -0.5),
        "w_ffn_out": nrm(ks[26], (DEPTH, D_FF, D_MODEL), D_FF ** -0.5),
        "norm_f_w": gain(ks[27], (D_MODEL,)),
    }


def reference(x, norm_mix_w, w_in, hgrn_lower_bounds, hgrn_norm_w, ssd_conv_w, ssd_conv_b, ssd_dt_bias,
              ssd_a_log, ssd_d, ssd_norm_w, gla_gate_w, gla_gate_b, gla_norm_w, lru_conv_w, lru_conv_b,
              lru_wa, lru_ba, lru_wx, lru_bx, lru_lambda, w_branch, w_out, norm_ffn_w, w_ffn_in,
              w_ffn_out, norm_f_w):
    bsz, seqlen, _ = x.shape
    split_idx = np.cumsum(IN_SPLITS)[:-1].tolist()
    lb_all = jnp.cumsum(jax.nn.softmax(hgrn_lower_bounds.astype(F32), axis=0), axis=0)
    lb_all = lb_all - lb_all[0:1]
    h = x
    for l in range(DEPTH):
        xn = rmsnorm(h, norm_mix_w[l])
        proj = xn @ w_in[l]
        (hq, hf, hi, hg, sz, sxbc, sdt, gq, gk, gv, gg, glr, lx, lg, mg) = jnp.split(proj, split_idx, axis=-1)
        ya = hgrn2_branch(hq, hf, hi, hg, lb_all[l], hgrn_norm_w[l])
        yb = ssd_branch(sz, sxbc, sdt, ssd_conv_w[l], ssd_conv_b[l], ssd_dt_bias[l], ssd_a_log[l],
                        ssd_d[l], ssd_norm_w[l])
        yc = gla_branch(gq, gk, gv, gg, glr, gla_gate_w[l], gla_gate_b[l], gla_norm_w[l])
        yd = rglru_branch(lx, lg, lru_conv_w[l], lru_conv_b[l], lru_wa[l], lru_ba[l], lru_wx[l], lru_bx[l],
                          lru_lambda[l])
        ys = jnp.stack([ya, yb, yc, yd], axis=2).astype(h.dtype)
        branch_out = jnp.einsum('blnw,nwd->blnd', ys, w_branch[l])
        gates = jax.nn.sigmoid(mg.astype(F32)).reshape(bsz, seqlen, N_BRANCHES, D_MODEL)
        merged = jnp.sum(gates * branch_out.astype(F32), axis=2).astype(h.dtype)
        h = h + (merged @ w_out[l]).astype(h.dtype)
        xn = rmsnorm(h, norm_ffn_w[l])
        gate_up = xn @ w_ffn_in[l]
        g_ff, u_ff = jnp.split(gate_up, [D_FF], axis=-1)
        h = h + ((jax.nn.silu(g_ff) * u_ff) @ w_ffn_out[l]).astype(h.dtype)
    return rmsnorm(h, norm_f_w)
```

```cpp
#include <hip/hip_runtime.h>
#include <hip/hip_cooperative_groups.h>
#include <cstdio>
#include <cstdint>
namespace cg = cooperative_groups;

#define LAS __attribute__((address_space(3)))
#define DI __device__ __forceinline__
typedef unsigned short bf16_t;
typedef short bf16x8 __attribute__((ext_vector_type(8)));
typedef float f32x4 __attribute__((ext_vector_type(4)));
typedef float f32x16 __attribute__((ext_vector_type(16)));
typedef unsigned u32x4 __attribute__((ext_vector_type(4)));
typedef unsigned u32x2 __attribute__((ext_vector_type(2)));
typedef float f32v2_t __attribute__((ext_vector_type(2)));

constexpr int DM = 1024, NB = 8, SEQ = 2048, MT = NB * SEQ, DEPTH = 2, DFF = 2816;
constexpr int W_IN_N = 10008;
constexpr float EPS = 1e-6f;
constexpr int PLD = 6208, NMIX = 6144;
constexpr int C_HQ = 0, C_SZ = 512, C_GG = 1024, C_LG = 1536, C_HF = 2048, C_HI = 2560, C_HG = 3072, C_XBC = 3584, C_DT = 4352, C_GLR = 4360,
              C_GQ = 4384, C_GK = 4640, C_GV = 4896, C_LX = 5408, C_END = 5920;
constexpr int C_GATES = 2048, C_MRG16 = 2048;
constexpr size_t OFF_PROJ = 0, SZ_PROJ = (size_t)MT * PLD * 2;
constexpr size_t OFF_HBF = OFF_PROJ + SZ_PROJ, SZ_HBF = (size_t)MT * DM * 2;
constexpr size_t OFF_W = OFF_HBF + SZ_HBF;
constexpr size_t WO_MIX = 0, WO_GATE = WO_MIX + (size_t)6144 * 1024 * 2, WO_BR = WO_GATE + (size_t)4096 * 1024 * 2, WO_OUT = WO_BR + (size_t)4 * 1024 * 512 * 2,
                 WO_FIN = WO_OUT + (size_t)1024 * 1024 * 2, WO_FOUT = WO_FIN + (size_t)5632 * 1024 * 2, W_LAYER = WO_FOUT + (size_t)1024 * 2816 * 2;
constexpr size_t OFF_SS = OFF_W + 2 * W_LAYER, SZ_SS = (size_t)2 * MT * 4;
constexpr size_t OFF_SSD = OFF_SS + SZ_SS, SZ_SSD = (size_t)MT * 8 * 4;
constexpr size_t OFF_SSP = OFF_SSD + SZ_SSD, SZ_SSP = (size_t)MT * 16 * 4;
constexpr int WQ_WORD = 3584;
constexpr size_t OFF_BAR = OFF_SSP + SZ_SSP, SZ_BAR = 16384;
constexpr size_t WS_NEED = OFF_BAR + SZ_BAR;
constexpr int LDS_BYTES = 147456;
constexpr int PTAB_OFF = LDS_BYTES - 256;
constexpr int XBST_OFF = LDS_BYTES - 272;

DI unsigned cvt_pk_bf16(float lo, float hi) { unsigned r; asm("s_nop 0\n\tv_cvt_pk_bf16_f32 %0, %1, %2" : "=v"(r) : "v"(lo), "v"(hi)); return r; }
DI float bf_lo(unsigned u) { return __uint_as_float(u << 16); }
DI float bf_hi(unsigned u) { return __uint_as_float(u & 0xffff0000u); }
DI float bf1(bf16_t u) { return __uint_as_float((unsigned)u << 16); }
DI bf16_t f2bf(float f) { return (bf16_t)(cvt_pk_bf16(f, 0.f) & 0xffffu); }
DI float sigmoidf_(float x) { return __builtin_amdgcn_rcpf(1.f + __expf(-x)); }
DI float siluf_(float x) { return x * __builtin_amdgcn_rcpf(1.f + __expf(-x)); }
DI float sigmoid_fast(float x) { return __builtin_amdgcn_rcpf(1.f + __expf(-x)); }
DI float silu_fast(float x) { return x * __builtin_amdgcn_rcpf(1.f + __expf(-x)); }
DI float softplusf_(float x) { return fmaxf(x, 0.f) + log1pf(__expf(-fabsf(x))); }
DI float clampe(float x) { return __builtin_amdgcn_fmed3f(x, -85.f, 85.f); }
DI float softplus_fast(float x) { return fmaxf(x, 0.f) + __logf(1.f + __expf(-fabsf(x))); }
DI float wave_sum(float v) {
#pragma unroll
    for (int o = 1; o < 64; o <<= 1) v += __shfl_xor(v, o);
    return v;
}

namespace pg8 {
constexpr int BM = 256, BK = 64, HALF = 128, HTB = HALF * BK * 2, STAGE_BYTES = 8 * HTB, NXCD = 8, WGM = 8;
__host__ __device__ __forceinline__ int lds_byte(int r, int c) { const int st = (r >> 4) * 2 + (c >> 5), rr = r & 15, cc = c & 31, ob = rr * 64 + cc * 2; return st * 1024 + (ob ^ (((ob >> 9) & 1) << 5)); }
__host__ __device__ __forceinline__ void stage_rc(int b, int& R, int& C) { const int st = b / 1024, sb = b % 1024, swz = sb ^ (((sb >> 9) & 1) << 5); R = (st >> 1) * 16 + swz / 64; C = (st & 1) * 32 + (swz % 64) / 2; }
__host__ __device__ __forceinline__ int perm32(int rho) { const int n = rho >> 4, i = rho & 15; return 8 * (i >> 2) + 4 * n + (i & 3); }
struct Unit { int pm, pn, aux; };
struct Gemm { const bf16_t* A; const bf16_t* Bt; int M, N, K, lda, ldb; };
struct StaticOrder {
    int nM, nN, nwg, G, c;
    __device__ void init(int M, int N, int G_, int c_) { nM = M / BM; nN = N / BM; nwg = nM * nN; G = G_; c = c_; }
    __device__ bool next(int i, Unit& u) const {
        const long L = (long)i * G + c; if (L >= nwg) return false;
        int wgid = (int)L; { const int q = nwg / NXCD, r = nwg % NXCD, xcd = wgid % NXCD, off = wgid / NXCD; wgid = (xcd < r ? xcd * (q + 1) : r * (q + 1) + (xcd - r) * q) + off; }
        const int nig = WGM * nN, gid = wgid / nig, fm = gid * WGM, gsz = (nM - fm) < WGM ? (nM - fm) : WGM;
        u.pm = fm + ((wgid % nig) % gsz); u.pn = (wgid % nig) / gsz; u.aux = 0; return true;
    }
    __device__ const char* abase(const Gemm& g, const Unit& u, size_t tstepA) const { return (const char*)g.A + (size_t)u.pm * tstepA; }
    __device__ const char* bbase(const Gemm& g, const Unit& u, size_t tstepB) const { return (const char*)g.Bt + (size_t)u.pn * tstepB; }
    __device__ int ntiles(const Gemm& g, const Unit&) const { return g.K / BK; }
};
struct GateOrder {
    StaticOrder S;
    __device__ bool next(int i, Unit& u) const { Unit t; if (!S.next(i >> 2, t)) return false; u.pm = t.pm; u.pn = t.pn + 4 * (i & 3); u.aux = 0; return true; }
    __device__ const char* abase(const Gemm& g, const Unit& u, size_t tstepA) const { return (const char*)g.A + (size_t)u.pm * tstepA; }
    __device__ const char* bbase(const Gemm& g, const Unit& u, size_t tstepB) const { return (const char*)g.Bt + (size_t)u.pn * tstepB; }
    __device__ int ntiles(const Gemm& g, const Unit&) const { return g.K / BK; }
};
struct BranchOrder {
    StaticOrder S;
    __device__ bool next(int i, Unit& u) const { Unit t; const int q = i / 5; if (!S.next(q, t)) return false; u.pm = t.pm; u.pn = t.pn; u.aux = i - 5 * q; return true; }
    static __device__ int br(int aux) { return aux - (aux >= 2 ? 1 : 0); }
    __device__ const char* abase(const Gemm& g, const Unit& u, size_t tstepA) const { return (const char*)g.A + (size_t)u.pm * tstepA + (size_t)(512 * br(u.aux) + (u.aux == 2 ? 256 : 0)) * 2; }
    __device__ const char* bbase(const Gemm& g, const Unit& u, size_t tstepB) const { return (const char*)g.Bt + (size_t)u.pn * tstepB + ((size_t)br(u.aux) * 1024 * 512 + (u.aux == 2 ? 256 : 0)) * 2; }
    __device__ int ntiles(const Gemm&, const Unit& u) const { return (u.aux == 1 || u.aux == 2) ? 4 : 8; }
};
typedef f32x4 Acc[2][2][4][2];

template <class Epi, class Sched>
__device__ __forceinline__ void gemm_phase(LAS unsigned char* lds, const Gemm g, const Sched& S, const Epi& E) {
    int tid_ = threadIdx.x; asm volatile("" : "+v"(tid_));
    const int tid = tid_, wid = __builtin_amdgcn_readfirstlane(tid >> 6), lane = tid & 63, wr = wid >> 2, wc = wid & 3, fr = lane & 15, fq = lane >> 4;
    unsigned voffA[2], voffB[2];
#pragma unroll
    for (int i = 0; i < 2; ++i) { int R, C; stage_rc(tid * 16 + i * 8192, R, C); const int Rb = (R & ~31) + perm32(R & 31);
        voffA[i] = (unsigned)(R * g.lda + C) * 2u; voffB[i] = (unsigned)(Rb * g.ldb + C) * 2u; }
    const size_t kstep = (size_t)(BK * 2);
    const size_t hstepA = (size_t)HALF * g.lda * 2, hstepB = (size_t)HALF * g.ldb * 2;
    const size_t tstepA = 2 * hstepA, tstepB = 2 * hstepB;
    const unsigned ldsw = (unsigned)wid * 1024u;
    const int aoff = lds_byte(wr * 64 + fr, fq * 8), boff = lds_byte(wc * 32 + fr, fq * 8);
#define PG8_SA(b, h) (((b) * 2 + (h)) * HTB)
#define PG8_SB(b, h) ((4 + (b) * 2 + (h)) * HTB)
#define PG8_STAGE(bufoff, gbase, voff) do { _Pragma("unroll") for (int _i = 0; _i < 2; ++_i) \
        __builtin_amdgcn_global_load_lds((const unsigned*)((const char*)(gbase) + (voff)[_i]), (LAS unsigned*)(lds + (bufoff) + ldsw + _i * 8192), 16, 0, 0); } while (0)
#define PG8_LDA(dst, b, h) do { _Pragma("unroll") for (int m = 0; m < 4; ++m) _Pragma("unroll") for (int k = 0; k < 2; ++k) dst[m][k] = *(const LAS bf16x8*)(lds + PG8_SA(b, h) + aoff + m * 2048 + k * 1024); } while (0)
#define PG8_LDB(dst, b, h) do { _Pragma("unroll") for (int n = 0; n < 2; ++n) _Pragma("unroll") for (int k = 0; k < 2; ++k) dst[n][k] = *(const LAS bf16x8*)(lds + PG8_SB(b, h) + boff + n * 2048 + k * 1024); } while (0)
#define PG8_MMA(ai, bj, At, Bt) do { __builtin_amdgcn_s_setprio(1); _Pragma("unroll") for (int m = 0; m < 4; ++m) _Pragma("unroll") for (int n = 0; n < 2; ++n) _Pragma("unroll") for (int k = 0; k < 2; ++k) \
        acc[ai][bj][m][n] = __builtin_amdgcn_mfma_f32_16x16x32_bf16(Bt[n][k], At[m][k], acc[ai][bj][m][n], 0, 0, 0); __builtin_amdgcn_s_setprio(0); } while (0)
#define PG8_WAIT_V(n) asm volatile("s_waitcnt vmcnt(" #n ")" ::: "memory")
#define PG8_WAIT_L(n) asm volatile("s_waitcnt lgkmcnt(" #n ")" ::: "memory")
#define PG8_BAR __builtin_amdgcn_s_barrier()
#define PG8_SCHED __builtin_amdgcn_sched_barrier(0)
    Unit cur, nxt; int ui = 0;
    if (!S.next(0, cur)) return;
    Acc acc;
#pragma unroll
    for (int a = 0; a < 2; ++a)
#pragma unroll
        for (int b = 0; b < 2; ++b)
#pragma unroll
            for (int m = 0; m < 4; ++m)
#pragma unroll
                for (int n = 0; n < 2; ++n) acc[a][b][m][n] = (f32x4){0.f, 0.f, 0.f, 0.f};
    bf16x8 At[4][2], B0[2][2], B1[2][2];
    const char* cA = S.abase(g, cur, tstepA); const char* cB = S.bbase(g, cur, tstepB);
    PG8_STAGE(PG8_SB(0, 0), cB, voffB); PG8_STAGE(PG8_SB(0, 1), cB + hstepB, voffB); PG8_STAGE(PG8_SA(0, 0), cA, voffA); PG8_STAGE(PG8_SA(0, 1), cA + hstepA, voffA);
    if (wr == 1) PG8_BAR;
    PG8_WAIT_V(2); PG8_BAR;
    PG8_STAGE(PG8_SB(1, 0), cB + kstep, voffB); PG8_STAGE(PG8_SA(1, 0), cA + kstep, voffA); PG8_STAGE(PG8_SB(1, 1), cB + hstepB + kstep, voffB);
    PG8_WAIT_V(6); PG8_BAR;
    for (;;) {
        const bool has_next = S.next(ui + 1, nxt);
        const char* nA = has_next ? S.abase(g, nxt, tstepA) : cA; const char* nB = has_next ? S.bbase(g, nxt, tstepB) : cB;
        const int nt = S.ntiles(g, cur);
        for (int t = 0; t < nt; t += 2) {
            const bool last = (t == nt - 2);
            const char* a1 = cA + (size_t)(t + 1) * kstep;
            const char* a2 = last ? nA : cA + (size_t)(t + 2) * kstep; const char* b2 = last ? nB : cB + (size_t)(t + 2) * kstep;
            const char* a3 = a2 + kstep; const char* b3 = b2 + kstep;
            PG8_LDB(B0, 0, 0); PG8_LDB(B1, 0, 1); PG8_SCHED; PG8_LDA(At, 0, 0); PG8_STAGE(PG8_SA(1, 1), a1 + hstepA, voffA);
            PG8_WAIT_V(8); PG8_WAIT_L(0); PG8_BAR; PG8_MMA(0, 0, At, B0); PG8_MMA(0, 1, At, B1); PG8_BAR; PG8_SCHED;
            PG8_LDA(At, 0, 1); PG8_STAGE(PG8_SB(0, 0), b2, voffB); PG8_STAGE(PG8_SB(0, 1), b2 + hstepB, voffB); PG8_STAGE(PG8_SA(0, 0), a2, voffA);
            PG8_WAIT_V(8); PG8_WAIT_L(0); PG8_BAR; PG8_MMA(1, 0, At, B0); PG8_MMA(1, 1, At, B1); PG8_BAR; PG8_SCHED;
            PG8_LDB(B0, 1, 0); PG8_LDB(B1, 1, 1); PG8_SCHED; PG8_LDA(At, 1, 0); PG8_STAGE(PG8_SA(0, 1), a2 + hstepA, voffA);
            PG8_WAIT_V(8); PG8_WAIT_L(0); PG8_BAR; PG8_MMA(0, 0, At, B0); PG8_MMA(0, 1, At, B1); PG8_BAR; PG8_SCHED;
            PG8_LDA(At, 1, 1); PG8_STAGE(PG8_SB(1, 0), b3, voffB); PG8_STAGE(PG8_SB(1, 1), b3 + hstepB, voffB); PG8_STAGE(PG8_SA(1, 0), a3, voffA);
            PG8_WAIT_V(8); PG8_WAIT_L(0); PG8_BAR; PG8_MMA(1, 0, At, B0); PG8_MMA(1, 1, At, B1); PG8_BAR; PG8_SCHED;
        }
        if (wr == 0) PG8_BAR;
        E(acc, cur, wr, wc, fr, fq);
        if (!has_next) break;
#pragma unroll
        for (int a = 0; a < 2; ++a)
#pragma unroll
            for (int b = 0; b < 2; ++b)
#pragma unroll
                for (int m = 0; m < 4; ++m)
#pragma unroll
                    for (int n = 0; n < 2; ++n) acc[a][b][m][n] = (f32x4){0.f, 0.f, 0.f, 0.f};
        cur = nxt; cA = nA; cB = nB; ++ui;
        if (wr == 1) PG8_BAR;
    }
    PG8_WAIT_V(0);
    PG8_BAR;
#undef PG8_SA
#undef PG8_SB
#undef PG8_STAGE
#undef PG8_LDA
#undef PG8_LDB
#undef PG8_MMA
#undef PG8_WAIT_V
#undef PG8_WAIT_L
#undef PG8_BAR
#undef PG8_SCHED
}

DI u32x4 ld_agent16(const bf16_t* p) { const unsigned long long* q = (const unsigned long long*)p;
    const unsigned long long a = __hip_atomic_load(q, __ATOMIC_RELAXED, __HIP_MEMORY_SCOPE_AGENT), b = __hip_atomic_load(q + 1, __ATOMIC_RELAXED, __HIP_MEMORY_SCOPE_AGENT);
    return (u32x4){(unsigned)a, (unsigned)(a >> 32), (unsigned)b, (unsigned)(b >> 32)}; }
DI u32x4 pack8(f32x4 v0, f32x4 v1) { u32x4 w; w.x = cvt_pk_bf16(v0[0], v0[1]); w.y = cvt_pk_bf16(v0[2], v0[3]); w.z = cvt_pk_bf16(v1[0], v1[1]); w.w = cvt_pk_bf16(v1[2], v1[3]); return w; }
template <int ACT> struct EpiScale {
    bf16_t* O; int ldc; const float* ss;
    DI void operator()(const Acc& acc, const Unit& u, int wr, int wc, int fr, int fq) const {
        const int row0 = u.pm * BM + wr * 64 + fr, col0 = u.pn * BM + wc * 32 + 8 * fq;
        const int asel = (ACT != 2) ? 0 : ((u.pn < 6 || u.pn == 12 || u.pn == 13) ? 1 : ((u.pn == 6 || u.pn == 7) ? 2 : 0));
#pragma unroll
        for (int ai = 0; ai < 2; ++ai)
#pragma unroll
            for (int m = 0; m < 4; ++m) {
                const int row = row0 + ai * HALF + m * 16; const float rs = rsqrtf(ss[row] * (1.0f / DM) + EPS);
                bf16_t* rowp = O + (size_t)row * ldc + col0;
#pragma unroll
                for (int bj = 0; bj < 2; ++bj) { f32x4 v0, v1;
                    if (ACT == 1) {
                        const float nrs = rs * (-1.4426950408889634f);
                        const f32x4 t0 = acc[ai][bj][m][0] * nrs, t1 = acc[ai][bj][m][1] * nrs;
                        f32x4 e0 = {__builtin_amdgcn_exp2f(t0[0]), __builtin_amdgcn_exp2f(t0[1]), __builtin_amdgcn_exp2f(t0[2]), __builtin_amdgcn_exp2f(t0[3])};
                        f32x4 e1 = {__builtin_amdgcn_exp2f(t1[0]), __builtin_amdgcn_exp2f(t1[1]), __builtin_amdgcn_exp2f(t1[2]), __builtin_amdgcn_exp2f(t1[3])};
                        e0 = e0 + 1.0f; e1 = e1 + 1.0f;
                        v0 = (f32x4){__builtin_amdgcn_rcpf(e0[0]), __builtin_amdgcn_rcpf(e0[1]), __builtin_amdgcn_rcpf(e0[2]), __builtin_amdgcn_rcpf(e0[3])};
                        v1 = (f32x4){__builtin_amdgcn_rcpf(e1[0]), __builtin_amdgcn_rcpf(e1[1]), __builtin_amdgcn_rcpf(e1[2]), __builtin_amdgcn_rcpf(e1[3])};
                    } else { v0 = acc[ai][bj][m][0] * rs; v1 = acc[ai][bj][m][1] * rs; }
                    if (ACT == 2) {
                        if (asel != 0) {
                            f32x4 t0, t1;
                            if (asel == 1) { t0 = v0 * (-1.4426950408889634f); t1 = v1 * (-1.4426950408889634f); }
                            else { t0 = (v0 * v0 * 0.044715f + 1.0f) * v0 * (-1.5957691216057308f * 1.4426950408889634f); t1 = (v1 * v1 * 0.044715f + 1.0f) * v1 * (-1.5957691216057308f * 1.4426950408889634f); }
                            f32x4 e0 = {__builtin_amdgcn_exp2f(t0[0]), __builtin_amdgcn_exp2f(t0[1]), __builtin_amdgcn_exp2f(t0[2]), __builtin_amdgcn_exp2f(t0[3])};
                            f32x4 e1 = {__builtin_amdgcn_exp2f(t1[0]), __builtin_amdgcn_exp2f(t1[1]), __builtin_amdgcn_exp2f(t1[2]), __builtin_amdgcn_exp2f(t1[3])};
                            e0 = e0 + 1.0f; e1 = e1 + 1.0f;
                            v0 = v0 * (f32x4){__builtin_amdgcn_rcpf(e0[0]), __builtin_amdgcn_rcpf(e0[1]), __builtin_amdgcn_rcpf(e0[2]), __builtin_amdgcn_rcpf(e0[3])};
                            v1 = v1 * (f32x4){__builtin_amdgcn_rcpf(e1[0]), __builtin_amdgcn_rcpf(e1[1]), __builtin_amdgcn_rcpf(e1[2]), __builtin_amdgcn_rcpf(e1[3])};
                        }
                    }
                    *(u32x4*)(rowp + bj * HALF) = pack8(v0, v1); }
            }
    }
};
struct EpiBranch {
    const bf16_t* gates; bf16_t* mrg; int ld; const float* ssd;
    DI void operator()(const Acc& acc, const Unit& u, int wr, int wc, int fr, int fq) const {
        const int row0 = u.pm * BM + wr * 64 + fr, col0 = u.pn * BM + wc * 32 + 8 * fq;
        const int n = BranchOrder::br(u.aux); const bool scaled = (n == 1); const int grp = (u.aux == 2) ? 1 : 0;
        const bf16_t* gate = gates + 1024 * n;
#pragma unroll
        for (int ai = 0; ai < 2; ++ai)
#pragma unroll
            for (int m = 0; m < 4; ++m) {
                const int row = row0 + ai * HALF + m * 16; float rs = 1.f;
                if (scaled) { const f32x4 q = *(const f32x4*)(ssd + (size_t)row * 8 + grp * 4); rs = rsqrtf(((q[0] + q[1]) + (q[2] + q[3])) * (1.0f / 256.0f) + EPS); }
#pragma unroll
                for (int bj = 0; bj < 2; ++bj) {
                    const size_t off = (size_t)row * ld + col0 + bj * HALF;
                    const u32x4 gw = *(const u32x4*)(gate + off);
                    f32x4 g0 = {bf_lo(gw.x), bf_hi(gw.x), bf_lo(gw.y), bf_hi(gw.y)}, g1 = {bf_lo(gw.z), bf_hi(gw.z), bf_lo(gw.w), bf_hi(gw.w)};
                    f32x4 v0 = acc[ai][bj][m][0] * g0, v1 = acc[ai][bj][m][1] * g1;
                    if (scaled) { v0 = v0 * rs; v1 = v1 * rs; }
                    if (u.aux != 0) { const u32x4 mw = ld_agent16(mrg + off);
                        v0 += (f32x4){bf_lo(mw.x), bf_hi(mw.x), bf_lo(mw.y), bf_hi(mw.y)}; v1 += (f32x4){bf_lo(mw.z), bf_hi(mw.z), bf_lo(mw.w), bf_hi(mw.w)}; }
                    *(u32x4*)(mrg + off) = pack8(v0, v1);
                }
            }
    }
};
struct EpiResid {
    const float* src32; float* dst32; bf16_t* hb; float* ssn;
    DI void operator()(const Acc& acc, const Unit& u, int wr, int wc, int fr, int fq) const {
        const int row0 = u.pm * BM + wr * 64 + fr, col0 = u.pn * BM + wc * 32 + 8 * fq;
#pragma unroll
        for (int ai = 0; ai < 2; ++ai)
#pragma unroll
            for (int m = 0; m < 4; ++m) {
                const int row = row0 + ai * HALF + m * 16; float s = 0.f;
#pragma unroll
                for (int bj = 0; bj < 2; ++bj) {
                    const size_t off = (size_t)row * DM + col0 + bj * HALF;
                    f32x4 r0, r1;
                    if (src32) { r0 = *(const f32x4*)(src32 + off); r1 = *(const f32x4*)(src32 + off + 4); }
                    else { const u32x4 w = *(const u32x4*)(hb + off); r0 = (f32x4){bf_lo(w.x), bf_hi(w.x), bf_lo(w.y), bf_hi(w.y)}; r1 = (f32x4){bf_lo(w.z), bf_hi(w.z), bf_lo(w.w), bf_hi(w.w)}; }
                    const f32x4 v0 = acc[ai][bj][m][0] + r0, v1 = acc[ai][bj][m][1] + r1;
                    if (dst32) { *(f32x4*)(dst32 + off) = v0; *(f32x4*)(dst32 + off + 4) = v1; }
                    else *(u32x4*)(hb + off) = pack8(v0, v1);
                    s += (v0[0] * v0[0] + v0[1] * v0[1]) + (v0[2] * v0[2] + v0[3] * v0[3]) + (v1[0] * v1[0] + v1[1] * v1[1]) + (v1[2] * v1[2] + v1[3] * v1[3]);
                }
                s += __shfl_xor(s, 16); s += __shfl_xor(s, 32);
                if (fq == 0) ssn[(size_t)row * 16 + u.pn * 4 + wc] = s;
            }
    }
};
struct EpiSwiglu {
    bf16_t* O; int ldo; const float* ss;
    DI void operator()(const Acc& acc, const Unit& u, int wr, int wc, int fr, int fq) const {
        const int row0 = u.pm * BM + wr * 64 + fr, col0 = u.pn * HALF + wc * 32 + 8 * fq;
#pragma unroll
        for (int ai = 0; ai < 2; ++ai)
#pragma unroll
            for (int m = 0; m < 4; ++m) {
                const int row = row0 + ai * HALF + m * 16; const float rs = rsqrtf(ss[row] * (1.0f / DM) + EPS);
                const float nrs = rs * (-1.4426950408889634f), rs2 = rs * rs;
                const f32x4 g0 = acc[ai][0][m][0], g1 = acc[ai][0][m][1];
                const f32x4 t0 = g0 * nrs, t1 = g1 * nrs;
                f32x4 e0 = {__builtin_amdgcn_exp2f(t0[0]), __builtin_amdgcn_exp2f(t0[1]), __builtin_amdgcn_exp2f(t0[2]), __builtin_amdgcn_exp2f(t0[3])};
                f32x4 e1 = {__builtin_amdgcn_exp2f(t1[0]), __builtin_amdgcn_exp2f(t1[1]), __builtin_amdgcn_exp2f(t1[2]), __builtin_amdgcn_exp2f(t1[3])};
                e0 = e0 + 1.0f; e1 = e1 + 1.0f;
                const f32x4 r0 = {__builtin_amdgcn_rcpf(e0[0]), __builtin_amdgcn_rcpf(e0[1]), __builtin_amdgcn_rcpf(e0[2]), __builtin_amdgcn_rcpf(e0[3])};
                const f32x4 r1 = {__builtin_amdgcn_rcpf(e1[0]), __builtin_amdgcn_rcpf(e1[1]), __builtin_amdgcn_rcpf(e1[2]), __builtin_amdgcn_rcpf(e1[3])};
                const f32x4 v0 = ((g0 * acc[ai][1][m][0]) * rs2) * r0, v1 = ((g1 * acc[ai][1][m][1]) * rs2) * r1;
                *(u32x4*)(O + (size_t)row * ldo + col0) = pack8(v0, v1);
            }
    }
};
}

struct Args {
    const float* in[27];
    float* out; unsigned char* ws; long long pad;
};
struct Ctx { LAS unsigned char* lds; float* out; unsigned char* ws;
    DI const float* in(int i) const { return *(const float* const LAS*)(lds + PTAB_OFF + 8 * i); } };
enum { I_X = 0, I_NMIX, I_WIN, I_HLB, I_HNW, I_SCW, I_SCB, I_SDTB, I_SALOG, I_SD, I_SNW, I_GGW, I_GGB, I_GNW, I_LCW, I_LCB, I_LWA, I_LBA, I_LWX, I_LBX, I_LLAM,
       I_WBR, I_WOUT, I_NFFN, I_WFIN, I_WFOUT, I_NF };

DI int mix_src(int n) {
    if (n < 512) return n;
    if (n < 1024) return 2048 + (n - 512);
    if (n < 1536) return 4360 + (n - 1024);
    if (n < 2048) return 5400 + (n - 1536);
    if (n < 2560) return 512 + (n - 2048);
    if (n < 3072) return 1024 + (n - 2560);
    if (n < 3584) return 1536 + (n - 3072);
    if (n < 4352) return 2560 + (n - 3584);
    if (n < 4360) return 3328 + (n - 4352);
    if (n < 4376) return 4872 + (n - 4360);
    if (n < 4384) return -1;
    if (n < 4640) return 3336 + (n - 4384);
    if (n < 4896) return 3592 + (n - 4640);
    if (n < 5408) return 3848 + (n - 4896);
    if (n < 5920) return 4888 + (n - 5408);
    return -1;
}
struct WJob { const float* W; bf16_t* WT; const float* scale; int ldw, ldt, k0, n0, mode, soff; };
DI int wsrc(const WJob& j, int np) {
    if (j.mode == 0) return np + j.soff;
    if (j.mode == 1) return mix_src(np);
    const int pn = np >> 8, bj = (np >> 7) & 1, q = np & 127; return bj * DFF + 128 * pn + q;
}
constexpr int WT_MIX = 16 * 24, WT_GATE = 16 * 16, WT_BR1 = 8 * 4, WT_OUT = 16 * 4, WT_FIN = 16 * 22, WT_FOUT = 44 * 4;
constexpr int WT_PER_L = WT_MIX + WT_GATE + 4 * WT_BR1 + WT_OUT + WT_FIN + WT_FOUT;
DI void wjob_decode(const Ctx& a, int it, WJob& j) {
    const int l = it / WT_PER_L; int r = it % WT_PER_L;
    unsigned char* wl = a.ws + OFF_W + (size_t)l * W_LAYER;
    const float* win = a.in(I_WIN) + (size_t)l * DM * W_IN_N;
    j.soff = 0; j.mode = 0; j.scale = nullptr;
    if (r < WT_MIX) { j.W = win; j.ldw = W_IN_N; j.WT = (bf16_t*)(wl + WO_MIX); j.ldt = DM; j.k0 = 64 * (r / 24); j.n0 = 256 * (r % 24); j.mode = 1; j.scale = a.in(I_NMIX) + l * DM; return; } r -= WT_MIX;
    if (r < WT_GATE) { j.W = win; j.ldw = W_IN_N; j.WT = (bf16_t*)(wl + WO_GATE); j.ldt = DM; j.k0 = 64 * (r / 16); j.n0 = 256 * (r % 16); j.soff = 5912; j.scale = a.in(I_NMIX) + l * DM; return; } r -= WT_GATE;
    if (r < 4 * WT_BR1) { const int n = r / WT_BR1, q = r % WT_BR1; j.W = a.in(I_WBR) + ((size_t)l * 4 + n) * 512 * DM; j.ldw = DM; j.WT = (bf16_t*)(wl + WO_BR) + (size_t)n * DM * 512; j.ldt = 512;
        j.k0 = 64 * (q / 4); j.n0 = 256 * (q % 4); j.scale = (n == 1) ? a.in(I_SNW) + l * 512 : nullptr; return; } r -= 4 * WT_BR1;
    if (r < WT_OUT) { j.W = a.in(I_WOUT) + (size_t)l * DM * DM; j.ldw = DM; j.WT = (bf16_t*)(wl + WO_OUT); j.ldt = DM; j.k0 = 64 * (r / 4); j.n0 = 256 * (r % 4); return; } r -= WT_OUT;
    if (r < WT_FIN) { j.W = a.in(I_WFIN) + (size_t)l * DM * 2 * DFF; j.ldw = 2 * DFF; j.WT = (bf16_t*)(wl + WO_FIN); j.ldt = DM; j.k0 = 64 * (r / 22); j.n0 = 256 * (r % 22); j.mode = 2; j.scale = a.in(I_NFFN) + l * DM; return; } r -= WT_FIN;
    j.W = a.in(I_WFOUT) + (size_t)l * DFF * DM; j.ldw = DM; j.WT = (bf16_t*)(wl + WO_FOUT); j.ldt = DFF; j.k0 = 64 * (r / 4); j.n0 = 256 * (r % 4);
}
DI void wjob_issue(const WJob& j, int tid, f32x4 (&regs)[8]) {
#pragma unroll
    for (int q = 0; q < 8; ++q) { const int idx = tid + 512 * q, kr = idx >> 6, n4 = idx & 63; const int src = wsrc(j, j.n0 + 4 * n4);
        regs[q] = (src >= 0) ? *(const f32x4*)(j.W + (size_t)(j.k0 + kr) * j.ldw + src) : (f32x4){0.f, 0.f, 0.f, 0.f}; }
}
#define BAR_LDS() do { asm volatile("s_waitcnt lgkmcnt(0)" ::: "memory"); __builtin_amdgcn_s_barrier(); asm volatile("" ::: "memory"); } while (0)

template <bool QUEUE>
DI void convert_weights(const Ctx& a, LAS unsigned char* lds, int tid, int first, int tend, int step, unsigned* wq) {
    LAS float* T = (LAS float*)lds;
    volatile LAS int* tick = (volatile LAS int*)(lds + 64 * 257 * 4 + 64);
    f32x4 regs[8]; WJob job, nj;
    int it = first;
    if (QUEUE) { if (tid == 0) tick[0] = first + (int)__hip_atomic_fetch_add(wq, 1u, __ATOMIC_RELAXED, __HIP_MEMORY_SCOPE_AGENT); BAR_LDS(); it = tick[0]; BAR_LDS(); }
    if (it < tend) { wjob_decode(a, it, job); wjob_issue(job, tid, regs); }
    while (it < tend) {
#pragma unroll
        for (int q = 0; q < 8; ++q) { const int idx = tid + 512 * q, kr = idx >> 6, n4 = idx & 63; LAS float* d = T + kr * 257 + 4 * n4;
            d[0] = regs[q][0]; d[1] = regs[q][1]; d[2] = regs[q][2]; d[3] = regs[q][3]; }
        if (QUEUE) { if (tid == 0) tick[0] = first + (int)__hip_atomic_fetch_add(wq, 1u, __ATOMIC_RELAXED, __HIP_MEMORY_SCOPE_AGENT); }
        BAR_LDS();
        const int nit = QUEUE ? tick[0] : it + step;
        if (nit < tend) { wjob_decode(a, nit, nj); wjob_issue(nj, tid, regs); }
        const int c = tid & 7;
        float sc[8];
#pragma unroll
        for (int i = 0; i < 8; ++i) sc[i] = job.scale ? job.scale[job.k0 + 8 * c + i] : 1.f;
#pragma unroll
        for (int q = 0; q < 4; ++q) { const int n = (tid + 512 * q) >> 3; const LAS float* sp = T + (8 * c) * 257 + n;
            u32x4 o; o.x = cvt_pk_bf16(sp[0 * 257] * sc[0], sp[1 * 257] * sc[1]); o.y = cvt_pk_bf16(sp[2 * 257] * sc[2], sp[3 * 257] * sc[3]);
            o.z = cvt_pk_bf16(sp[4 * 257] * sc[4], sp[5 * 257] * sc[5]); o.w = cvt_pk_bf16(sp[6 * 257] * sc[6], sp[7 * 257] * sc[7]);
            *(u32x4*)(job.WT + (size_t)(job.n0 + n) * job.ldt + job.k0 + 8 * c) = o; }
        BAR_LDS();
        job = nj; it = nit;
    }
}

DI void phase_prologue(const Ctx& a, LAS unsigned char* lds, int G) {
    int tid_ = threadIdx.x; asm volatile("" : "+v"(tid_));
    const int tid = tid_, lane = tid & 63, wave = tid >> 6;
    const int gw = blockIdx.x * 8 + wave, NGW = G * 8;
    float* ss = (float*)(a.ws + OFF_SS);
    convert_weights<false>(a, lds, tid, blockIdx.x, WT_MIX, G, nullptr);
    bf16_t* hb = (bf16_t*)(a.ws + OFF_HBF);
    for (int m = 2 * gw; m < MT; m += 2 * NGW) {
        f32x4 v[2][4];
#pragma unroll
        for (int r = 0; r < 2; ++r) { const f32x4* xr = (const f32x4*)(a.in(I_X) + (size_t)(m + r) * DM) + lane;
#pragma unroll
            for (int j = 0; j < 4; ++j) v[r][j] = xr[64 * j]; }
#pragma unroll
        for (int r = 0; r < 2; ++r) { u32x2* hrow = (u32x2*)(hb + (size_t)(m + r) * DM) + lane; float sq = 0.f;
#pragma unroll
            for (int j = 0; j < 4; ++j) { const f32x4 t = v[r][j]; sq += (t[0] * t[0] + t[1] * t[1]) + (t[2] * t[2] + t[3] * t[3]);
                u32x2 w; w.x = cvt_pk_bf16(t[0], t[1]); w.y = cvt_pk_bf16(t[2], t[3]); hrow[64 * j] = w; }
            sq = wave_sum(sq);
            if (lane == 0) ss[m + r] = sq; }
    }
}

DI f32x16 mma_nt(const LAS bf16_t* A, int lda, int m0, const LAS bf16_t* B, int ldb, int n0, int K, f32x16 acc, int lane) {
    const int r = lane & 31, h = lane >> 5;
    const LAS bf16_t* ap = A + (m0 + r) * lda + 8 * h; const LAS bf16_t* bp = B + (n0 + r) * ldb + 8 * h;
    for (int ks = 0; ks < K; ks += 16) {
        const bf16x8 av = *(const LAS bf16x8*)(ap + ks), bv = *(const LAS bf16x8*)(bp + ks);
        acc = __builtin_amdgcn_mfma_f32_32x32x16_bf16(av, bv, acc, 0, 0, 0);
    }
    return acc;
}
DI int crow(int reg, int h) { return (reg & 3) + 8 * (reg >> 2) + 4 * h; }
#define ZERO16(x) do { _Pragma("unroll") for (int _z = 0; _z < 16; ++_z) (x)[_z] = 0.f; } while (0)

template <int DK, bool HG>
DI void mixer_gla(const Ctx& a, LAS unsigned char* lds, int l, int b, int hd) {
    constexpr int LQ = DK + 8, LT = 72;
    int tid_ = threadIdx.x; asm volatile("" : "+v"(tid_));
    const int tid = tid_, lane = tid & 63, w = __builtin_amdgcn_readfirstlane(tid >> 6), r32 = lane & 31, hh = lane >> 5;
    bf16_t* proj = (bf16_t*)(a.ws + OFF_PROJ);
    LAS bf16_t* Qs = (LAS bf16_t*)lds;
    LAS bf16_t* Ks = Qs + 64 * LQ;
    LAS float* Os = (LAS float*)lds;
    LAS bf16_t* Q2s = Ks + 64 * LQ;
    LAS bf16_t* KTs = Q2s + 64 * LQ;
    LAS bf16_t* VTs = KTs + DK * LT;
    LAS bf16_t* Ps = VTs + 128 * LT;
    LAS bf16_t* STs = Ps + 64 * LT;
    LAS float* part = (LAS float*)(STs + 128 * LQ);
    LAS float* e1s = part + 8 * DK;
    LAS float* e2s = e1s + DK;
    LAS bf16_t* GLs = (LAS bf16_t*)(e2s + DK);
    constexpr int NST = DK / 64;
    f32x16 S[NST];
#pragma unroll
    for (int s = 0; s < NST; ++s) ZERO16(S[s]);
    for (int i = tid; i < 128 * LQ / 2; i += 512) ((LAS unsigned*)STs)[i] = 0u;
    const int cq = HG ? C_HQ + hd * 128 : C_GQ + hd * 64;
    const int cf = HG ? C_HF + hd * 128 : C_GK + hd * 64;
    const int cv = HG ? C_HI + hd * 128 : C_GV + hd * 128;
    const int cg_ = HG ? C_HG + hd * 128 : C_GG + hd * 128;
    const int cout_ = HG ? C_HQ + hd * 128 : C_GG + hd * 128;
    float lb0 = 0.f, lb1 = 0.f;
    float gw_[16]; float gb_ = 0.f;
    if (HG) {
        if (l > 0) { const float* p = a.in(I_HLB); const int c0 = hd * 128 + 2 * lane;
            lb0 = 1.f / (1.f + __expf(p[c0] - p[512 + c0])); lb1 = 1.f / (1.f + __expf(p[c0 + 1] - p[512 + c0 + 1])); }
#pragma unroll
        for (int i = 0; i < 16; ++i) gw_[i] = 0.f;
    } else {
#pragma unroll
        for (int i = 0; i < 16; ++i) gw_[i] = a.in(I_GGW)[((size_t)l * 16 + i) * 256 + hd * 64 + lane];
        gb_ = a.in(I_GGB)[l * 256 + hd * 64 + lane];
    }
    const float* nw = (HG ? a.in(I_HNW) : a.in(I_GNW)) + l * 128;
    const int e8 = tid & 7;
    unsigned pq[8], pf[8], pv[8]; u32x4 pgl = {0u, 0u, 0u, 0u};
    const size_t rowb = (size_t)b * SEQ;
#define GLA_PREFETCH(cn) do { const size_t r0_ = rowb + 64 * (cn); \
        _Pragma("unroll") for (int t = 0; t < 8; ++t) { const bf16_t* rp = proj + (r0_ + 8 * w + t) * PLD; \
            if (HG) { pq[t] = *(const unsigned*)(rp + cq + 2 * lane); pf[t] = *(const unsigned*)(rp + cf + 2 * lane); } \
            else { pq[t] = rp[cq + lane]; pf[t] = rp[cf + lane]; } \
            pv[t] = *(const unsigned*)(rp + cv + 2 * lane); } \
        if (!HG && tid < 128) pgl = *(const u32x4*)(proj + (r0_ + (tid >> 1)) * PLD + C_GLR + 8 * (tid & 1)); } while (0)
    GLA_PREFETCH(0);
    if (!HG && tid < 128) *(LAS u32x4*)(GLs + (tid >> 1) * 16 + 8 * (tid & 1)) = pgl;
    __syncthreads();

    for (int c = 0; c < SEQ / 64; ++c) {
        const size_t row0 = rowb + 64 * c;
        bf16_t* rpd = proj + (row0 + (tid >> 3)) * PLD;
        float lf[8][2], qv[8][2], kv[8][2]; unsigned vv[8];
        f32v2_t fV[8], qV[8], kV[8];
        if (HG) {
            const f32v2_t lbv = {lb0, lb1}, omlb = {1.f - lb0, 1.f - lb1};
#pragma unroll
            for (int t = 0; t < 8; ++t) {
                const unsigned q2 = pq[t], f2 = pf[t]; vv[t] = pv[t];
                const f32v2_t fx = {bf_lo(f2), bf_hi(f2)};
                const f32v2_t ex = fx * (-1.4426950408889634f);
                f32v2_t en = {__builtin_amdgcn_exp2f(ex[0]), __builtin_amdgcn_exp2f(ex[1])};
                en = en + 1.0f;
                const f32v2_t sg = {__builtin_amdgcn_rcpf(en[0]), __builtin_amdgcn_rcpf(en[1])};
                const f32v2_t f = omlb * sg + lbv;
                fV[t] = f; kV[t] = 1.0f - f;
                qV[t] = (f32v2_t){bf_lo(q2), bf_hi(q2)};
            }
            f32v2_t sp = fV[0];
#pragma unroll
            for (int t = 1; t < 8; ++t) sp = sp * fV[t];
            part[w * DK + 2 * lane] = __logf(fmaxf(sp[0], 1.2e-37f)); part[w * DK + 2 * lane + 1] = __logf(fmaxf(sp[1], 1.2e-37f));
        } else {
#pragma unroll
            for (int t = 0; t < 8; ++t) {
                vv[t] = pv[t];
                qv[t][0] = bf1((bf16_t)pq[t]) * 0.125f; kv[t][0] = bf1((bf16_t)pf[t]); qv[t][1] = 0.f; kv[t][1] = 0.f;
                const u32x4 g0 = *(const LAS u32x4*)(GLs + (8 * w + t) * 16), g1 = *(const LAS u32x4*)(GLs + (8 * w + t) * 16 + 8);
                float d = gb_;
                d += bf_lo(g0.x) * gw_[0] + bf_hi(g0.x) * gw_[1] + bf_lo(g0.y) * gw_[2] + bf_hi(g0.y) * gw_[3] + bf_lo(g0.z) * gw_[4] + bf_hi(g0.z) * gw_[5] + bf_lo(g0.w) * gw_[6] + bf_hi(g0.w) * gw_[7];
                d += bf_lo(g1.x) * gw_[8] + bf_hi(g1.x) * gw_[9] + bf_lo(g1.y) * gw_[10] + bf_hi(g1.y) * gw_[11] + bf_lo(g1.z) * gw_[12] + bf_hi(g1.z) * gw_[13] + bf_lo(g1.w) * gw_[14] + bf_hi(g1.w) * gw_[15];
                lf[t][0] = -softplus_fast(-d) * (1.0f / 16.0f); lf[t][1] = 0.f;
            }
            float s0 = 0.f;
#pragma unroll
            for (int t = 0; t < 8; ++t) s0 += lf[t][0];
            part[w * DK + lane] = s0;
        }
        const u32x4 ga = *(const u32x4*)(rpd + cg_ + 16 * e8), gb2 = *(const u32x4*)(rpd + cg_ + 16 * e8 + 8);
        if (c + 1 < SEQ / 64) GLA_PREFETCH(c + 1);
        BAR_LDS();
        if (HG) {
            float offs[2], br[2], bl[2];
#pragma unroll
            for (int cc = 0; cc < 2; ++cc) { const int d = 2 * lane + cc; offs[cc] = 0.f; br[cc] = 0.f; bl[cc] = 0.f;
#pragma unroll
                for (int ww = 0; ww < 8; ++ww) { const float pvv = part[ww * DK + d]; if (ww < w) offs[cc] += pvv; if (ww < 4) br[cc] += pvv; bl[cc] += pvv; }
                if (w == 0) { e1s[d] = __expf(clampe(bl[cc])); e2s[d] = __expf(clampe(bl[cc] - br[cc])); } }
            f32v2_t bc = {__expf(clampe(offs[0] - br[0])), __expf(clampe(offs[1] - br[1]))}; unsigned kt0[4], kt1[4];
            const f32v2_t ebr = {__expf(fmaxf(br[0], -87.f)), __expf(fmaxf(br[1], -87.f))};
#pragma unroll
            for (int t = 0; t < 8; ++t) {
                bc = bc * fV[t];
                bc = (f32v2_t){fmaxf(bc[0], 1.2e-37f), fmaxf(bc[1], 1.2e-37f)};
                const f32v2_t qa = qV[t] * bc;
                const f32v2_t q2 = qa * ebr;
                const f32v2_t rc = {__builtin_amdgcn_rcpf(bc[0]), __builtin_amdgcn_rcpf(bc[1])};
                const f32v2_t ka = kV[t] * rc;
                *(LAS unsigned*)(Qs + (8 * w + t) * LQ + 2 * lane) = cvt_pk_bf16(qa[0], qa[1]);
                *(LAS unsigned*)(Q2s + (8 * w + t) * LQ + 2 * lane) = cvt_pk_bf16(q2[0], q2[1]);
                const unsigned kp = cvt_pk_bf16(ka[0], ka[1]);
                *(LAS unsigned*)(Ks + (8 * w + t) * LQ + 2 * lane) = kp;
                if (t & 1) { kt0[t >> 1] |= kp << 16; kt1[t >> 1] |= kp & 0xffff0000u; } else { kt0[t >> 1] = kp & 0xffffu; kt1[t >> 1] = kp >> 16; }
            }
            *(LAS u32x4*)(KTs + (2 * lane) * LT + 8 * w) = (u32x4){kt0[0], kt0[1], kt0[2], kt0[3]};
            *(LAS u32x4*)(KTs + (2 * lane + 1) * LT + 8 * w) = (u32x4){kt1[0], kt1[1], kt1[2], kt1[3]};
        } else {
            const int d = lane;
            float offs = 0.f, br = 0.f, bl = 0.f;
#pragma unroll
            for (int ww = 0; ww < 8; ++ww) { const float pvv = part[ww * DK + d]; if (ww < w) offs += pvv; if (ww < 4) br += pvv; bl += pvv; }
            if (w == 0) { e1s[d] = __expf(clampe(bl)); e2s[d] = __expf(clampe(bl - br)); }
            float bc = offs; unsigned ktp[4];
            const float ebr = __expf(fmaxf(br, -87.f));
#pragma unroll
            for (int t = 0; t < 8; ++t) {
                bc += lf[t][0];
                const float e1_ = __expf(clampe(bc - br)); const float q1 = qv[t][0] * e1_, q2 = q1 * ebr, k1 = kv[t][0] * __builtin_amdgcn_rcpf(e1_);
                const unsigned qq = cvt_pk_bf16(q1, q2), kk = cvt_pk_bf16(k1, 0.f);
                Qs[(8 * w + t) * LQ + d] = (bf16_t)(qq & 0xffffu); Q2s[(8 * w + t) * LQ + d] = (bf16_t)(qq >> 16); Ks[(8 * w + t) * LQ + d] = (bf16_t)(kk & 0xffffu);
                if (t & 1) ktp[t >> 1] |= kk << 16; else ktp[t >> 1] = kk & 0xffffu;
            }
            *(LAS u32x4*)(KTs + d * LT + 8 * w) = (u32x4){ktp[0], ktp[1], ktp[2], ktp[3]};
        }
        {
            u32x4 v0, v1;
            v0.x = (vv[0] & 0xffffu) | (vv[1] << 16); v0.y = (vv[2] & 0xffffu) | (vv[3] << 16); v0.z = (vv[4] & 0xffffu) | (vv[5] << 16); v0.w = (vv[6] & 0xffffu) | (vv[7] << 16);
            v1.x = (vv[0] >> 16) | (vv[1] & 0xffff0000u); v1.y = (vv[2] >> 16) | (vv[3] & 0xffff0000u); v1.z = (vv[4] >> 16) | (vv[5] & 0xffff0000u); v1.w = (vv[6] >> 16) | (vv[7] & 0xffff0000u);
            *(LAS u32x4*)(VTs + (2 * lane) * LT + 8 * w) = v0; *(LAS u32x4*)(VTs + (2 * lane + 1) * LT + 8 * w) = v1;
        }
        BAR_LDS();
        if (w < 4) {
            const int jt = w >> 1, it = w & 1;
            f32x16 sc; ZERO16(sc);
            if (it >= jt) sc = mma_nt(Ks, LQ, 32 * jt, Qs, LQ, 32 * it, DK, sc, lane);
            const int i = 32 * it + r32;
#pragma unroll
            for (int g = 0; g < 4; ++g) {
                const int j0 = 32 * jt + 8 * g + 4 * hh;
                float p0 = (i >= j0) ? sc[4 * g] : 0.f, p1 = (i >= j0 + 1) ? sc[4 * g + 1] : 0.f, p2 = (i >= j0 + 2) ? sc[4 * g + 2] : 0.f, p3 = (i >= j0 + 3) ? sc[4 * g + 3] : 0.f;
                *(LAS u32x2*)(Ps + i * LT + j0) = (u32x2){cvt_pk_bf16(p0, p1), cvt_pk_bf16(p2, p3)};
            }
        }
        const int oit = w >> 2, ovt = w & 3;
        f32x16 oacc; ZERO16(oacc);
        oacc = mma_nt(Q2s, LQ, 32 * oit, STs, LQ, 32 * ovt, DK, oacc, lane);
#pragma unroll
        for (int s = 0; s < NST; ++s) {
            const int q = NST * w + s, dt = q >> 2, vt = q & 3;
            f32x16 tmp; ZERO16(tmp);
            tmp = mma_nt(KTs, LT, 32 * dt, VTs, LT, 32 * vt, 64, tmp, lane);
#pragma unroll
            for (int g = 0; g < 4; ++g) {
                const f32x4 x1 = *(const LAS f32x4*)(e1s + 32 * dt + 8 * g + 4 * hh), x2 = *(const LAS f32x4*)(e2s + 32 * dt + 8 * g + 4 * hh);
                { const f32x4 so = {S[s][4 * g], S[s][4 * g + 1], S[s][4 * g + 2], S[s][4 * g + 3]}, tv = {tmp[4 * g], tmp[4 * g + 1], tmp[4 * g + 2], tmp[4 * g + 3]};
                  const f32x4 sn = x1 * so + x2 * tv; S[s][4 * g] = sn[0]; S[s][4 * g + 1] = sn[1]; S[s][4 * g + 2] = sn[2]; S[s][4 * g + 3] = sn[3]; }
            }
        }
        BAR_LDS();
        oacc = mma_nt(Ps, LT, 32 * oit, VTs, LT, 32 * ovt, 64, oacc, lane);
#pragma unroll
        for (int rg = 0; rg < 16; ++rg) Os[(32 * oit + crow(rg, hh)) * 132 + 32 * ovt + r32] = oacc[rg];
#pragma unroll
        for (int s = 0; s < NST; ++s) {
            const int q = NST * w + s, dt = q >> 2, vt = q & 3;
#pragma unroll
            for (int g = 0; g < 4; ++g)
                *(LAS u32x2*)(STs + (32 * vt + r32) * LQ + 32 * dt + 8 * g + 4 * hh) = (u32x2){cvt_pk_bf16(S[s][4 * g], S[s][4 * g + 1]), cvt_pk_bf16(S[s][4 * g + 2], S[s][4 * g + 3])};
        }
        if (!HG && tid < 128 && c + 1 < SEQ / 64) *(LAS u32x4*)(GLs + (tid >> 1) * 16 + 8 * (tid & 1)) = pgl;
        BAR_LDS();
        {
            const int i = tid >> 3;
            const LAS f32x4* op = (const LAS f32x4*)(Os + i * 132 + 16 * e8);
            f32x4 o[4]; float ssq = 0.f;
#pragma unroll
            for (int j = 0; j < 4; ++j) { o[j] = op[j]; ssq += (o[j][0] * o[j][0] + o[j][1] * o[j][1]) + (o[j][2] * o[j][2] + o[j][3] * o[j][3]); }
            ssq += __shfl_xor(ssq, 1); ssq += __shfl_xor(ssq, 2); ssq += __shfl_xor(ssq, 4);
            const float rs = rsqrtf(ssq * (1.0f / 128.0f) + EPS);
            const unsigned gu[8] = {ga.x, ga.y, ga.z, ga.w, gb2.x, gb2.y, gb2.z, gb2.w};
            float nwr[16];
#pragma unroll
            for (int q = 0; q < 4; ++q) { const f32x4 t4 = *(const f32x4*)(nw + 16 * e8 + 4 * q); nwr[4 * q] = t4[0]; nwr[4 * q + 1] = t4[1]; nwr[4 * q + 2] = t4[2]; nwr[4 * q + 3] = t4[3]; }
            unsigned ou[8];
#pragma unroll
            for (int j = 0; j < 8; ++j) {
                const f32v2_t ov = {o[j >> 1][(2 * j) & 3], o[j >> 1][(2 * j + 1) & 3]}, nv = {nwr[2 * j], nwr[2 * j + 1]}, gv = {bf_lo(gu[j]), bf_hi(gu[j])};
                const f32v2_t yv = (ov * rs) * (nv * gv);
                ou[j] = cvt_pk_bf16(yv[0], yv[1]);
            }
            *(u32x4*)(rpd + cout_ + 16 * e8) = (u32x4){ou[0], ou[1], ou[2], ou[3]}; *(u32x4*)(rpd + cout_ + 16 * e8 + 8) = (u32x4){ou[4], ou[5], ou[6], ou[7]};
        }
    }
#undef GLA_PREFETCH
    __syncthreads();
}

DI void mixer_ssd(const Ctx& a, LAS unsigned char* lds, int l, int b, int hd) {
    constexpr int LT = 72;
    int tid_ = threadIdx.x; asm volatile("" : "+v"(tid_));
    const int tid = tid_, lane = tid & 63, w = __builtin_amdgcn_readfirstlane(tid >> 6), r32 = lane & 31, hh = lane >> 5;
    const int grp = hd >> 2;
    bf16_t* proj = (bf16_t*)(a.ws + OFF_PROJ);
    float* ssd = (float*)(a.ws + OFF_SSD);
    LAS bf16_t* Bs = (LAS bf16_t*)lds;
    LAS bf16_t* Cs = Bs + 64 * LT;
    LAS bf16_t* BTs = Cs + 64 * LT;
    LAS bf16_t* XTs = BTs + 64 * LT;
    LAS bf16_t* XWs = XTs + 64 * LT;
    LAS bf16_t* Xb = XWs + 64 * LT;
    LAS bf16_t* Ps = Xb + 64 * LT;
    LAS bf16_t* Ss = Ps + 64 * LT;
    LAS float* Os = (LAS float*)(Ss + 64 * LT);
    LAS float* dts = Os + 64 * 68;
    LAS float* acs = dts + 64;
    LAS float* Xs32 = acs + 64;
    LAS float* eacs = Xs32 + 64 * 66;
    LAS float* wts = eacs + 64;
    f32x16 S; ZERO16(S);
    for (int i = tid; i < 64 * LT / 2; i += 512) ((LAS unsigned*)Ss)[i] = 0u;
    const int arr = tid >> 7, pr = tid & 31, tg = (tid & 127) >> 5;
    int ccol = 0;
    if (arr == 0) ccol = hd * 64 + 2 * pr; else if (arr == 1) ccol = 512 + grp * 64 + 2 * pr; else ccol = 640 + grp * 64 + 2 * pr;
    float cw[4][2], cb[2];
    if (arr < 3) {
#pragma unroll
        for (int k = 0; k < 4; ++k) { cw[k][0] = a.in(I_SCW)[((size_t)l * 4 + k) * 768 + ccol]; cw[k][1] = a.in(I_SCW)[((size_t)l * 4 + k) * 768 + ccol + 1]; }
        cb[0] = a.in(I_SCB)[l * 768 + ccol]; cb[1] = a.in(I_SCB)[l * 768 + ccol + 1];
    } else {
#pragma unroll
        for (int k = 0; k < 4; ++k) { cw[k][0] = 0.f; cw[k][1] = 0.f; }
        cb[0] = cb[1] = 0.f;
    }
    const float dtb = a.in(I_SDTB)[l * 8 + hd], aneg = -__expf(a.in(I_SALOG)[l * 8 + hd]), dsk = a.in(I_SD)[l * 8 + hd];
    const size_t rowb = (size_t)b * SEQ;
    unsigned pwin[19]; unsigned pdr = 0u;
#define SSD_PREFETCH(cn) do { if (arr < 3) { _Pragma("unroll") for (int t = 0; t < 19; ++t) { const int tt = 64 * (cn) + 16 * tg + t - 3; \
            pwin[t] = (tt >= 0) ? *(const unsigned*)(proj + (rowb + tt) * PLD + C_XBC + ccol) : 0u; } } \
        else if (w == 6) pdr = proj[(rowb + 64 * (cn) + lane) * PLD + C_DT + hd]; } while (0)
    SSD_PREFETCH(0);
    __syncthreads();
    for (int c = 0; c < SEQ / 64; ++c) {
        const size_t row0 = rowb + 64 * c;
        bf16_t* rpd = proj + (row0 + (tid >> 3)) * PLD + C_SZ + hd * 64 + 8 * (tid & 7);
        float xs[16][2];
        if (arr < 3) {
#pragma unroll
            for (int t = 0; t < 16; ++t) {
                const float y0 = cb[0] + cw[0][0] * bf_lo(pwin[t]) + cw[1][0] * bf_lo(pwin[t + 1]) + cw[2][0] * bf_lo(pwin[t + 2]) + cw[3][0] * bf_lo(pwin[t + 3]);
                const float y1 = cb[1] + cw[0][1] * bf_hi(pwin[t]) + cw[1][1] * bf_hi(pwin[t + 1]) + cw[2][1] * bf_hi(pwin[t + 2]) + cw[3][1] * bf_hi(pwin[t + 3]);
                xs[t][0] = silu_fast(y0); xs[t][1] = silu_fast(y1);
            }
            if (arr == 0) {
#pragma unroll
                for (int t = 0; t < 16; ++t) { *(LAS unsigned*)(Xb + (16 * tg + t) * LT + 2 * pr) = cvt_pk_bf16(xs[t][0], xs[t][1]);
                    *(LAS f32v2_t*)(Xs32 + (16 * tg + t) * 66 + 2 * pr) = (f32v2_t){xs[t][0], xs[t][1]}; }
            } else {
                LAS bf16_t* dst = (arr == 1) ? Bs : Cs;
#pragma unroll
                for (int t = 0; t < 16; ++t) *(LAS unsigned*)(dst + (16 * tg + t) * LT + 2 * pr) = cvt_pk_bf16(xs[t][0], xs[t][1]);
                if (arr == 1) {
#pragma unroll
                    for (int e = 0; e < 2; ++e) {
                        u32x4 p0, p1;
                        p0.x = cvt_pk_bf16(xs[0][e], xs[1][e]); p0.y = cvt_pk_bf16(xs[2][e], xs[3][e]); p0.z = cvt_pk_bf16(xs[4][e], xs[5][e]); p0.w = cvt_pk_bf16(xs[6][e], xs[7][e]);
                        p1.x = cvt_pk_bf16(xs[8][e], xs[9][e]); p1.y = cvt_pk_bf16(xs[10][e], xs[11][e]); p1.z = cvt_pk_bf16(xs[12][e], xs[13][e]); p1.w = cvt_pk_bf16(xs[14][e], xs[15][e]);
                        *(LAS u32x4*)(BTs + (2 * pr + e) * LT + 16 * tg) = p0; *(LAS u32x4*)(BTs + (2 * pr + e) * LT + 16 * tg + 8) = p1;
                    }
                }
            }
        } else if (w == 6) {
            const float dt = softplus_fast(bf1((bf16_t)pdr) + dtb);
            float cs = dt * aneg;
#pragma unroll
            for (int o = 1; o < 64; o <<= 1) { const float v = __shfl_up(cs, o); if (lane >= o) cs += v; }
            dts[lane] = dt; acs[lane] = cs;
            eacs[lane] = __expf(cs); wts[lane] = __expf(__shfl(cs, 63) - cs);
        }
        const u32x4 zb = *(const u32x4*)rpd;
        if (c + 1 < SEQ / 64) SSD_PREFETCH(c + 1);
        BAR_LDS();
        {
            const int pr2 = tid & 31, tgx = tid >> 5;
            float xd[4][2], xw[4][2];
#pragma unroll
            for (int t = 0; t < 4; ++t) { const int tk = 4 * tgx + t; const f32v2_t xv = *(const LAS f32v2_t*)(Xs32 + tk * 66 + 2 * pr2);
                const float d = dts[tk], wgt = wts[tk];
                xd[t][0] = xv[0] * d; xd[t][1] = xv[1] * d; xw[t][0] = xd[t][0] * wgt; xw[t][1] = xd[t][1] * wgt; }
#pragma unroll
            for (int e = 0; e < 2; ++e) {
                *(LAS u32x2*)(XTs + (2 * pr2 + e) * LT + 4 * tgx) = (u32x2){cvt_pk_bf16(xd[0][e], xd[1][e]), cvt_pk_bf16(xd[2][e], xd[3][e])};
                *(LAS u32x2*)(XWs + (2 * pr2 + e) * LT + 4 * tgx) = (u32x2){cvt_pk_bf16(xw[0][e], xw[1][e]), cvt_pk_bf16(xw[2][e], xw[3][e])};
            }
        }
        BAR_LDS();
        f32x16 yoff; ZERO16(yoff);
        const int tI = (w >> 1) & 1, tJ = w & 1;
        if (w < 4) {
            const int jt = tI, it = tJ;
            f32x16 sc; ZERO16(sc);
            if (it >= jt) sc = mma_nt(Bs, LT, 32 * jt, Cs, LT, 32 * it, 64, sc, lane);
            const int i = 32 * it + r32; const float ai = acs[i];
#pragma unroll
            for (int g = 0; g < 4; ++g) {
                const int j0 = 32 * jt + 8 * g + 4 * hh; const f32x4 aj = *(const LAS f32x4*)(acs + j0);
                float p[4];
#pragma unroll
                for (int j = 0; j < 4; ++j) p[j] = (i >= j0 + j) ? sc[4 * g + j] * __expf(ai - aj[j]) : 0.f;
                *(LAS u32x2*)(Ps + i * LT + j0) = (u32x2){cvt_pk_bf16(p[0], p[1]), cvt_pk_bf16(p[2], p[3])};
            }
        } else {
            yoff = mma_nt(Cs, LT, 32 * tI, Ss, LT, 32 * tJ, 64, yoff, lane);
        }
        BAR_LDS();
        if (w >= 4) {
            f32x16 yd; ZERO16(yd);
            yd = mma_nt(Ps, LT, 32 * tI, XTs, LT, 32 * tJ, 64, yd, lane);
#pragma unroll
            for (int rg = 0; rg < 16; ++rg) { const int i = 32 * tI + crow(rg, hh); Os[i * 68 + 32 * tJ + r32] = yd[rg] + eacs[i] * yoff[rg]; }
        } else {
            f32x16 tmp; ZERO16(tmp);
            tmp = mma_nt(BTs, LT, 32 * tI, XWs, LT, 32 * tJ, 64, tmp, lane);
            const float dec = eacs[63];
#pragma unroll
            for (int rg = 0; rg < 16; ++rg) S[rg] = dec * S[rg] + tmp[rg];
#pragma unroll
            for (int g = 0; g < 4; ++g)
                *(LAS u32x2*)(Ss + (32 * tJ + r32) * LT + 32 * tI + 8 * g + 4 * hh) = (u32x2){cvt_pk_bf16(S[4 * g], S[4 * g + 1]), cvt_pk_bf16(S[4 * g + 2], S[4 * g + 3])};
        }
        BAR_LDS();
        {
            const int i = tid >> 3, e8 = tid & 7;
            const LAS f32x4* op = (const LAS f32x4*)(Os + i * 68 + 8 * e8);
            const f32x4 o0 = op[0], o1 = op[1];
            const u32x4 xb = *(const LAS u32x4*)(Xb + i * LT + 8 * e8);
            float y[8];
            y[0] = (o0[0] + dsk * bf_lo(xb.x)) * bf_lo(zb.x); y[1] = (o0[1] + dsk * bf_hi(xb.x)) * bf_hi(zb.x);
            y[2] = (o0[2] + dsk * bf_lo(xb.y)) * bf_lo(zb.y); y[3] = (o0[3] + dsk * bf_hi(xb.y)) * bf_hi(zb.y);
            y[4] = (o1[0] + dsk * bf_lo(xb.z)) * bf_lo(zb.z); y[5] = (o1[1] + dsk * bf_hi(xb.z)) * bf_hi(zb.z);
            y[6] = (o1[2] + dsk * bf_lo(xb.w)) * bf_lo(zb.w); y[7] = (o1[3] + dsk * bf_hi(xb.w)) * bf_hi(zb.w);
            float ssq = 0.f;
#pragma unroll
            for (int j = 0; j < 8; ++j) ssq += y[j] * y[j];
            ssq += __shfl_xor(ssq, 1); ssq += __shfl_xor(ssq, 2); ssq += __shfl_xor(ssq, 4);
            if (e8 == 0) ssd[(row0 + i) * 8 + hd] = ssq;
            *(u32x4*)rpd = (u32x4){cvt_pk_bf16(y[0], y[1]), cvt_pk_bf16(y[2], y[3]), cvt_pk_bf16(y[4], y[5]), cvt_pk_bf16(y[6], y[7])};
        }
        BAR_LDS();
    }
#undef SSD_PREFETCH
}

DI void mixer_lru(const Ctx& a, LAS unsigned char* lds, int l, int b, int kb) {
    constexpr int LT = 72, LF = 68;
    int tid_ = threadIdx.x; asm volatile("" : "+v"(tid_));
    const int tid = tid_, lane = tid & 63, w = __builtin_amdgcn_readfirstlane(tid >> 6), r32 = lane & 31, hh = lane >> 5;
    bf16_t* proj = (bf16_t*)(a.ws + OFF_PROJ);
    LAS bf16_t* Us = (LAS bf16_t*)lds;
    LAS bf16_t* WTs = Us + 64 * LT;
    LAS float* U32 = (LAS float*)(WTs + 2 * 64 * LT);
    LAS float* As = U32 + 64 * LF;
    LAS float* Ms = As + 64 * LF;
    LAS float* Gs = Ms + 64 * LF;
    LAS float* GA = Gs + 64 * LF;
    LAS float* GH = GA + 8 * 64;
    for (int i = tid; i < 2 * 64 * 64; i += 512) { const int mat = i >> 12, d = (i >> 6) & 63, e = i & 63;
        const float v = (mat ? a.in(I_LWX) : a.in(I_LWA))[(((size_t)l * 8 + kb) * 64 + d) * 64 + e];
        WTs[(mat * 64 + e) * LT + d] = f2bf(v); }
    const int pr = tid & 31, tg = tid >> 5, ch = kb * 64 + 2 * pr;
    float cw[4][2], cb[2];
#pragma unroll
    for (int k = 0; k < 4; ++k) { cw[k][0] = a.in(I_LCW)[((size_t)l * 4 + k) * 512 + ch]; cw[k][1] = a.in(I_LCW)[((size_t)l * 4 + k) * 512 + ch + 1]; }
    cb[0] = a.in(I_LCB)[l * 512 + ch]; cb[1] = a.in(I_LCB)[l * 512 + ch + 1];
    const int mat = w >> 2, tm = (w >> 1) & 1, tn = w & 1, eg = kb * 64 + 32 * tn + r32;
    const float gbias = (mat ? a.in(I_LBX) : a.in(I_LBA))[l * 512 + eg];
    const float spl = -8.f * softplusf_(-a.in(I_LLAM)[l * 512 + eg]);
    float hstate = 0.f;
    const size_t rowb = (size_t)b * SEQ;
    unsigned pwin[7];
#define LRU_PREFETCH(cn) do { _Pragma("unroll") for (int t = 0; t < 7; ++t) { const int tt = 64 * (cn) + 4 * tg + t - 3; \
        pwin[t] = (tt >= 0) ? *(const unsigned*)(proj + (rowb + tt) * PLD + C_LX + ch) : 0u; } } while (0)
    LRU_PREFETCH(0);
    __syncthreads();
    for (int c = 0; c < SEQ / 64; ++c) {
        const size_t row0 = rowb + 64 * c;
        bf16_t* gp0 = proj + (row0 + 8 * w) * PLD + C_LG + kb * 64 + lane;
        {
#pragma unroll
            for (int t = 0; t < 4; ++t) {
                const float u0 = cb[0] + cw[0][0] * bf_lo(pwin[t]) + cw[1][0] * bf_lo(pwin[t + 1]) + cw[2][0] * bf_lo(pwin[t + 2]) + cw[3][0] * bf_lo(pwin[t + 3]);
                const float u1 = cb[1] + cw[0][1] * bf_hi(pwin[t]) + cw[1][1] * bf_hi(pwin[t + 1]) + cw[2][1] * bf_hi(pwin[t + 2]) + cw[3][1] * bf_hi(pwin[t + 3]);
                *(LAS unsigned*)(Us + (4 * tg + t) * LT + 2 * pr) = cvt_pk_bf16(u0, u1);
                U32[(4 * tg + t) * LF + 2 * pr] = u0; U32[(4 * tg + t) * LF + 2 * pr + 1] = u1;
            }
        }
        bf16_t pgt[8];
#pragma unroll
        for (int t = 0; t < 8; ++t) pgt[t] = gp0[(size_t)t * PLD];
        if (c + 1 < SEQ / 64) LRU_PREFETCH(c + 1);
        BAR_LDS();
        {
            f32x16 pre; ZERO16(pre);
            pre = mma_nt(Us, LT, 32 * tm, WTs + mat * 64 * LT, LT, 32 * tn, 64, pre, lane);
            const int e = 32 * tn + r32;
#pragma unroll
            for (int rg = 0; rg < 16; ++rg) {
                const int t = 32 * tm + crow(rg, hh);
                const float sg = sigmoid_fast(pre[rg] + gbias);
                if (mat == 0) { const float la = spl * sg; As[t * LF + e] = __expf(la); Ms[t * LF + e] = __builtin_amdgcn_sqrtf(fmaxf(1.f - __expf(2.f * la), 0.f)); }
                else Gs[t * LF + e] = sg * U32[t * LF + e];
            }
        }
        BAR_LDS();
        float hl[8], ap[8];
        {
            float hloc = 0.f, apr = 1.f;
#pragma unroll
            for (int t = 0; t < 8; ++t) { const int tt = 8 * w + t; const float av = As[tt * LF + lane], bv = Ms[tt * LF + lane] * Gs[tt * LF + lane];
                hloc = av * hloc + bv; apr *= av; hl[t] = hloc; ap[t] = apr; }
            GA[w * 64 + lane] = apr; GH[w * 64 + lane] = hloc;
        }
        BAR_LDS();
        {
            float carry = hstate, cin = hstate;
#pragma unroll
            for (int ww = 0; ww < 8; ++ww) { carry = GA[ww * 64 + lane] * carry + GH[ww * 64 + lane]; if (ww + 1 == w) cin = carry; }
            if (w == 0) cin = hstate;
            hstate = carry;
#pragma unroll
            for (int t = 0; t < 8; ++t) {
                const float ge = bf1(pgt[t]);
                gp0[(size_t)t * PLD] = f2bf((hl[t] + ap[t] * cin) * ge);
            }
        }
    }
#undef LRU_PREFETCH
    __syncthreads();
}

DI void phase_mixers(const Ctx& a, LAS unsigned char* lds, int l, int G) {
    const int it = blockIdx.x;
    const int mb = it & 7, mk = it >> 3;
    if (mk < 4) mixer_gla<128, true>(a, lds, l, mb, mk);
    else if (mk < 8) mixer_gla<64, false>(a, lds, l, mb, mk - 4);
    else if (mk < 16) mixer_ssd(a, lds, l, mb, mk - 8);
    else if (mk < 24) mixer_lru(a, lds, l, mb, mk - 16);
    if (l == 0) {
        __syncthreads();
        int tid_ = threadIdx.x; asm volatile("" : "+v"(tid_));
        convert_weights<true>(a, lds, tid_, WT_MIX, DEPTH * WT_PER_L, 0, (unsigned*)(a.ws + OFF_BAR) + WQ_WORD);
    }
}


#define XB_TMO      128
#define XB_XCNT(j)  (256  + 64 * (j))
#define XB_XSUB(j)  (1280 + 64 * (j))
#define XB_XGEN(j)  (2304 + 64 * (j))
#define XB_TOP      3328
#define XB_TOPGEN   3392
#define XCD_BAR_WORDS 3456
#define XB_SPIN_CAP (1u << 18)
DI unsigned xb_ld(unsigned* p)              { return __hip_atomic_load(p, __ATOMIC_RELAXED, __HIP_MEMORY_SCOPE_AGENT); }
DI unsigned xb_add(unsigned* p, unsigned v) { return __hip_atomic_fetch_add(p, v, __ATOMIC_RELAXED, __HIP_MEMORY_SCOPE_AGENT); }
DI unsigned xb_xcc_id() { return (unsigned)__builtin_amdgcn_s_getreg((3 << 11) | 20) & 0xFu; }
#define XB_SPIN(cond, bar) do { unsigned _sp = 0; while (cond) { __builtin_amdgcn_s_sleep(1); \
    if ((++_sp & 255u) == 0u) { if (xb_ld(&(bar)[XB_TMO])) break; if (_sp > XB_SPIN_CAP) { atomicAdd(&(bar)[XB_TMO], 1u); break; } } } } while (0)
struct XcdBarrier { unsigned* bar; unsigned x; volatile LAS unsigned* st; };
DI XcdBarrier xcd_barrier_post(unsigned* bar, volatile LAS unsigned* st) {
    XcdBarrier b; b.bar = bar; b.x = xb_xcc_id(); b.st = st;
    if (threadIdx.x == 0) (void)xb_add(&bar[XB_XCNT(b.x)], 1u);
    return b;
}
DI void xcd_barrier_complete(unsigned* bar, unsigned x, unsigned& nloc, unsigned& nx) {
    const unsigned G = gridDim.x * gridDim.y * gridDim.z;
    unsigned sum, cnt, mine, sp = 0u;
    for (;;) {
        sum = 0u; cnt = 0u; mine = 0u;
#pragma unroll
        for (unsigned j = 0; j < 16; ++j) { const unsigned c = xb_ld(&bar[XB_XCNT(j)]); sum += c; cnt += (c > 0u) ? 1u : 0u; mine = (j == x) ? c : mine; }
        if (sum == G) break;
        __builtin_amdgcn_s_sleep(1);
        if ((++sp & 255u) == 0u) { if (xb_ld(&bar[XB_TMO])) break; if (sp > XB_SPIN_CAP) { atomicAdd(&bar[XB_TMO], 1u); break; } }
    }
    nloc = mine > 0u ? mine : 1u; nx = cnt > 0u ? cnt : 1u;
}
DI void xcd_barrier(const XcdBarrier& b) {
    asm volatile("s_waitcnt vmcnt(0)" ::: "memory");
    __syncthreads();
    if (threadIdx.x == 0) {
        unsigned* bar = b.bar;
        __builtin_amdgcn_s_waitcnt(0);
        unsigned nloc = b.st[0], nx = b.st[1];
        if (nloc == 0u) { xcd_barrier_complete(bar, b.x, nloc, nx); b.st[0] = nloc; b.st[1] = nx; }
        const unsigned old = xb_add(&bar[XB_XSUB(b.x)], 1u);
        const unsigned gen = old / nloc;
        if (old + 1u == (gen + 1u) * nloc) {
            __builtin_amdgcn_fence(__ATOMIC_RELEASE, "agent");
            asm volatile("s_waitcnt vmcnt(0)" ::: "memory");
            const unsigned og = xb_add(&bar[XB_TOP], 1u);
            const unsigned tg = og / nx;
            if (og + 1u == (tg + 1u) * nx) xb_add(&bar[XB_TOPGEN], 1u);
            else XB_SPIN(xb_ld(&bar[XB_TOPGEN]) == tg, bar);
            __builtin_amdgcn_fence(__ATOMIC_ACQUIRE, "agent");
            xb_add(&bar[XB_XGEN(b.x)], 1u);
            asm volatile("s_waitcnt vmcnt(0)" ::: "memory");
        } else {
            XB_SPIN(xb_ld(&bar[XB_XGEN(b.x)]) == gen, bar);
            __builtin_amdgcn_fence(__ATOMIC_ACQUIRE, "agent");
            asm volatile("s_waitcnt vmcnt(0)" ::: "memory");
        }
    }
    __syncthreads();
}

DI float ss_sum16(const float* p16) {
    const f32x4* p = (const f32x4*)p16; const f32x4 a = p[0], b = p[1], c = p[2], d = p[3];
    return (((a[0] + a[1]) + (a[2] + a[3])) + ((b[0] + b[1]) + (b[2] + b[3]))) + (((c[0] + c[1]) + (c[2] + c[3])) + ((d[0] + d[1]) + (d[2] + d[3])));
}
DI void ss_reduce_own(const float* ssp, float* ss, const pg8::StaticOrder& S) {
    pg8::Unit u; int prev = -1;
    for (int i = 0; S.next(i, u); ++i) {
        if (u.pm != prev) { prev = u.pm; if (threadIdx.x < 256) { const int row = u.pm * 256 + threadIdx.x; ss[row] = ss_sum16(ssp + (size_t)row * 16); } }
    }
    asm volatile("s_waitcnt vmcnt(0)" ::: "memory");
    __syncthreads();
}

__global__ void __launch_bounds__(512, 2) fwd(Args ka) {
    extern __shared__ __attribute__((aligned(16))) unsigned char lds_raw[];
    LAS unsigned char* lds = (LAS unsigned char*)lds_raw;
    if (threadIdx.x < 27) *(const float* LAS*)(lds + PTAB_OFF + 8 * threadIdx.x) = ka.in[threadIdx.x];
    if (threadIdx.x < 2) ((LAS unsigned*)(lds + XBST_OFF))[threadIdx.x] = 0u;
    __syncthreads();
    const XcdBarrier xb = xcd_barrier_post((unsigned*)(ka.ws + OFF_BAR), (volatile LAS unsigned*)(lds + XBST_OFF));
    Ctx a; a.lds = lds; a.out = ka.out; a.ws = ka.ws;
    cg::grid_group grid = cg::this_grid();
    const int G = gridDim.x, bid = blockIdx.x;
    unsigned char* ws = a.ws;
    bf16_t* proj = (bf16_t*)(ws + OFF_PROJ);
    bf16_t* hbf = (bf16_t*)(ws + OFF_HBF);
    float* ss = (float*)(ws + OFF_SS);
    float* ssd = (float*)(ws + OFF_SSD);
    float* ssp = (float*)(ws + OFF_SSP);

    phase_prologue(a, lds, G);
    if (ka.pad != 0) grid.sync();
    xcd_barrier(xb);

#pragma unroll 1
    for (int l = 0; l < DEPTH; ++l) {
        unsigned char* wl = ws + OFF_W + (size_t)l * W_LAYER;
        float* ss_mix = ss; float* ss_ffn = ss + MT;
        {
            pg8::Gemm g{hbf, (const bf16_t*)(wl + WO_MIX), MT, NMIX, DM, DM, DM}; pg8::StaticOrder S; S.init(MT, NMIX, G, bid);
            if (l > 0) ss_reduce_own(ssp, ss_mix, S);
            pg8::EpiScale<2> E{proj, PLD, ss_mix};
            pg8::gemm_phase(lds, g, S, E);
        }
        xcd_barrier(xb);
        phase_mixers(a, lds, l, G);
        xcd_barrier(xb);
        {
            pg8::StaticOrder S; S.init(MT, DM, G, bid);
            {
                pg8::GateOrder GS{S};
                pg8::Gemm g{hbf, (const bf16_t*)(wl + WO_GATE), MT, 4 * DM, DM, DM, DM};
                pg8::EpiScale<1> E{proj + C_GATES, PLD, ss_mix};
                pg8::gemm_phase(lds, g, GS, E);
            }
            {
                pg8::BranchOrder BS{S};
                pg8::Gemm g{proj, (const bf16_t*)(wl + WO_BR), MT, DM, 512, PLD, 512};
                pg8::EpiBranch E{proj + C_GATES, proj + C_MRG16, PLD, ssd};
                pg8::gemm_phase(lds, g, BS, E);
            }
        }
        xcd_barrier(xb);
        {
            pg8::Gemm g{proj + C_MRG16, (const bf16_t*)(wl + WO_OUT), MT, DM, DM, PLD, DM}; pg8::StaticOrder S; S.init(MT, DM, G, bid);
            pg8::EpiResid E{(l == 0) ? a.in(I_X) : (const float*)nullptr, nullptr, hbf, ssp};
            pg8::gemm_phase(lds, g, S, E);
        }
        xcd_barrier(xb);
        {
            pg8::Gemm g{hbf, (const bf16_t*)(wl + WO_FIN), MT, 2 * DFF, DM, DM, DM}; pg8::StaticOrder S; S.init(MT, 2 * DFF, G, bid);
            ss_reduce_own(ssp, ss_ffn, S);
            pg8::EpiSwiglu E{proj, PLD, ss_ffn};
            pg8::gemm_phase(lds, g, S, E);
        }
        xcd_barrier(xb);
        {
            pg8::Gemm g{proj, (const bf16_t*)(wl + WO_FOUT), MT, DM, DFF, PLD, DFF}; pg8::StaticOrder S; S.init(MT, DM, G, bid);
            pg8::EpiResid E{nullptr, nullptr, hbf, ssp};
            pg8::gemm_phase(lds, g, S, E);
        }
        xcd_barrier(xb);
    }
    {
        int tid_ = threadIdx.x; asm volatile("" : "+v"(tid_));
        const int tid = tid_, lane = tid & 63, wave = tid >> 6;
        const f32x4* nf = (const f32x4*)a.in(I_NF);
        const f32x4 n0 = nf[2 * lane], n1 = nf[2 * lane + 1], n2 = nf[2 * (lane + 64)], n3 = nf[2 * (lane + 64) + 1];
        for (int m0 = 4 * (bid * 8 + wave); m0 < MT; m0 += 4 * G * 8) {
            u32x4 w0[4], w1[4]; float sq[4];
#pragma unroll
            for (int r = 0; r < 4; ++r) { const u32x4* hrow = (const u32x4*)(hbf + (size_t)(m0 + r) * DM); w0[r] = hrow[lane]; w1[r] = hrow[lane + 64]; sq[r] = ss_sum16(ssp + (size_t)(m0 + r) * 16); }
#pragma unroll
            for (int r = 0; r < 4; ++r) {
                const float rs = rsqrtf(sq[r] * (1.0f / DM) + EPS);
                f32x4* orow = (f32x4*)(a.out + (size_t)(m0 + r) * DM);
                orow[2 * lane] = (f32x4){bf_lo(w0[r].x), bf_hi(w0[r].x), bf_lo(w0[r].y), bf_hi(w0[r].y)} * rs * n0;
                orow[2 * lane + 1] = (f32x4){bf_lo(w0[r].z), bf_hi(w0[r].z), bf_lo(w0[r].w), bf_hi(w0[r].w)} * rs * n1;
                orow[2 * (lane + 64)] = (f32x4){bf_lo(w1[r].x), bf_hi(w1[r].x), bf_lo(w1[r].y), bf_hi(w1[r].y)} * rs * n2;
                orow[2 * (lane + 64) + 1] = (f32x4){bf_lo(w1[r].z), bf_hi(w1[r].z), bf_lo(w1[r].w), bf_hi(w1[r].w)} * rs * n3;
            }
        }
    }
}

extern "C" void kernel_launch(void* const* d_in, const int* in_sizes, int n_in, void* d_out, int out_size, void* d_ws, size_t ws_size, hipStream_t stream) {
    static int grid = 0;
    if (grid == 0) {
        if (n_in != 27 || out_size != MT * DM || ws_size < WS_NEED) { fprintf(stderr, "kernel_launch: unexpected shapes (n_in %d out %d ws %zu need %zu)\n", n_in, out_size, ws_size, (size_t)WS_NEED); grid = -1; return; }
        int dev = 0, cus = 0, per_cu = 0;
        (void)hipGetDevice(&dev);
        (void)hipDeviceGetAttribute(&cus, hipDeviceAttributeMultiprocessorCount, dev);
        (void)hipFuncSetAttribute((const void*)fwd, hipFuncAttributeMaxDynamicSharedMemorySize, LDS_BYTES);
        (void)hipOccupancyMaxActiveBlocksPerMultiprocessor(&per_cu, (const void*)fwd, 512, LDS_BYTES);
        if (per_cu < 1) per_cu = 1;
        if (per_cu > 1) per_cu = 1;
        grid = cus * per_cu;
        if (grid < 192) { fprintf(stderr, "kernel_launch: needs >= 192 resident workgroups, got %d\n", grid); grid = -1; return; }
    }
    if (grid < 0) return;
    (void)hipMemsetAsync((unsigned char*)d_ws + OFF_BAR, 0, SZ_BAR, stream);
    Args a{};
    for (int i = 0; i < 27; ++i) a.in[i] = (const float*)d_in[i];
    a.out = (float*)d_out; a.ws = (unsigned char*)d_ws; a.pad = 0;
    void* args[] = {&a};
    hipError_t e = hipLaunchCooperativeKernel((const void*)fwd, dim3(grid), dim3(512), args, LDS_BYTES, stream);
    if (e != hipSuccess) fprintf(stderr, "cooperative launch failed: %s (grid %d)\n", hipGetErrorString(e), grid);
}
```

```cpp
#include <hip/hip_runtime.h>
#include <hip/hip_cooperative_groups.h>
#include <cstdio>
#include <cstdint>
namespace cg = cooperative_groups;

#define LAS __attribute__((address_space(3)))
#define DI __device__ __forceinline__
typedef unsigned short bf16_t;
typedef short bf16x8 __attribute__((ext_vector_type(8)));
typedef float f32x4 __attribute__((ext_vector_type(4)));
typedef float f32x16 __attribute__((ext_vector_type(16)));
typedef unsigned u32x4 __attribute__((ext_vector_type(4)));
typedef unsigned u32x2 __attribute__((ext_vector_type(2)));
typedef float f32v2_t __attribute__((ext_vector_type(2)));

constexpr int DM = 1024, NB = 8, SEQ = 2048, MT = NB * SEQ, DEPTH = 2, DFF = 2816;
constexpr int W_IN_N = 10008;
constexpr float EPS = 1e-6f;
constexpr int PLD = 6208, NMIX = 6144;
constexpr int C_HQ = 0, C_SZ = 512, C_GG = 1024, C_LG = 1536, C_HF = 2048, C_HI = 2560, C_HG = 3072, C_XBC = 3584, C_DT = 4352, C_GLR = 4360,
              C_GQ = 4384, C_GK = 4640, C_GV = 4896, C_LX = 5408, C_END = 5920;
constexpr int C_GATES = 2048, C_MRG16 = 2048 + 3 * 1024;     constexpr int C_UNUSED_ = 0;
constexpr size_t OFF_PROJ = 0, SZ_PROJ = (size_t)MT * PLD * 2;
constexpr size_t OFF_HBF = OFF_PROJ + SZ_PROJ, SZ_HBF = (size_t)MT * DM * 2;
constexpr size_t OFF_W = OFF_HBF + SZ_HBF;
constexpr size_t WO_MIX = 0, WO_GATE = WO_MIX + (size_t)6144 * 1024 * 2, WO_BR = WO_GATE + (size_t)4096 * 1024 * 2, WO_OUT = WO_BR + (size_t)4 * 1024 * 512 * 2,
                 WO_FIN = WO_OUT + (size_t)1024 * 1024 * 2, WO_FOUT = WO_FIN + (size_t)5632 * 1024 * 2, W_LAYER = WO_FOUT + (size_t)1024 * 2816 * 2;
constexpr size_t OFF_SS = OFF_W + 2 * W_LAYER, SZ_SS = (size_t)2 * MT * 4;
constexpr size_t OFF_SSD = OFF_SS + SZ_SS, SZ_SSD = (size_t)MT * 8 * 4;
constexpr size_t OFF_SSP = OFF_SSD + SZ_SSD, SZ_SSP = (size_t)MT * 16 * 4;
constexpr int WQ_WORD = 3584;
constexpr size_t OFF_BAR = OFF_SSP + SZ_SSP, SZ_BAR = 16384;
constexpr size_t WS_NEED = OFF_BAR + SZ_BAR;
constexpr int LDS_BYTES = 147456;
constexpr int PTAB_OFF = LDS_BYTES - 256;
constexpr int XBST_OFF = LDS_BYTES - 272;

DI unsigned cvt_pk_bf16(float lo, float hi) { unsigned r; asm("s_nop 0\n\tv_cvt_pk_bf16_f32 %0, %1, %2" : "=v"(r) : "v"(lo), "v"(hi)); return r; }
DI float bf_lo(unsigned u) { return __uint_as_float(u << 16); }
DI float bf_hi(unsigned u) { return __uint_as_float(u & 0xffff0000u); }
DI float bf1(bf16_t u) { return __uint_as_float((unsigned)u << 16); }
DI bf16_t f2bf(float f) { return (bf16_t)(cvt_pk_bf16(f, 0.f) & 0xffffu); }
DI float sigmoidf_(float x) { return __builtin_amdgcn_rcpf(1.f + __expf(-x)); }
DI float siluf_(float x) { return x * __builtin_amdgcn_rcpf(1.f + __expf(-x)); }
DI float sigmoid_fast(float x) { return __builtin_amdgcn_rcpf(1.f + __expf(-x)); }
DI float silu_fast(float x) { return x * __builtin_amdgcn_rcpf(1.f + __expf(-x)); }
DI float softplusf_(float x) { return fmaxf(x, 0.f) + log1pf(__expf(-fabsf(x))); }
DI float clampe(float x) { return __builtin_amdgcn_fmed3f(x, -85.f, 85.f); }
DI float softplus_fast(float x) { return fmaxf(x, 0.f) + __logf(1.f + __expf(-fabsf(x))); }
DI float wave_sum(float v) {
#pragma unroll
    for (int o = 1; o < 64; o <<= 1) v += __shfl_xor(v, o);
    return v;
}

namespace pg8 {
constexpr int BM = 256, BK = 64, HALF = 128, HTB = HALF * BK * 2, STAGE_BYTES = 8 * HTB, NXCD = 8, WGM = 8;
__host__ __device__ __forceinline__ int lds_byte(int r, int c) { const int st = (r >> 4) * 2 + (c >> 5), rr = r & 15, cc = c & 31, ob = rr * 64 + cc * 2; return st * 1024 + (ob ^ (((ob >> 9) & 1) << 5)); }
__host__ __device__ __forceinline__ void stage_rc(int b, int& R, int& C) { const int st = b / 1024, sb = b % 1024, swz = sb ^ (((sb >> 9) & 1) << 5); R = (st >> 1) * 16 + swz / 64; C = (st & 1) * 32 + (swz % 64) / 2; }
__host__ __device__ __forceinline__ int perm32(int rho) { const int n = rho >> 4, i = rho & 15; return 8 * (i >> 2) + 4 * n + (i & 3); }
struct Unit { int pm, pn, aux; };
struct Gemm { const bf16_t* A; const bf16_t* Bt; int M, N, K, lda, ldb; };
struct StaticOrder {
    int nM, nN, nwg, G, c;
    __device__ void init(int M, int N, int G_, int c_) { nM = M / BM; nN = N / BM; nwg = nM * nN; G = G_; c = c_; }
    __device__ bool next(int i, Unit& u) const {
        const long L = (long)i * G + c; if (L >= nwg) return false;
        int wgid = (int)L; { const int q = nwg / NXCD, r = nwg % NXCD, xcd = wgid % NXCD, off = wgid / NXCD; wgid = (xcd < r ? xcd * (q + 1) : r * (q + 1) + (xcd - r) * q) + off; }
        const int nig = WGM * nN, gid = wgid / nig, fm = gid * WGM, gsz = (nM - fm) < WGM ? (nM - fm) : WGM;
        u.pm = fm + ((wgid % nig) % gsz); u.pn = (wgid % nig) / gsz; u.aux = 0; return true;
    }
    __device__ const char* abase(const Gemm& g, const Unit& u, size_t tstepA) const { return (const char*)g.A + (size_t)u.pm * tstepA; }
    __device__ const char* bbase(const Gemm& g, const Unit& u, size_t tstepB) const { return (const char*)g.Bt + (size_t)u.pn * tstepB; }
    __device__ int ntiles(const Gemm& g, const Unit&) const { return g.K / BK; }
};
struct GateOrder {
    StaticOrder S;
    __device__ bool next(int i, Unit& u) const { Unit t; if (!S.next(i >> 2, t)) return false; u.pm = t.pm; u.pn = t.pn + 4 * (i & 3); u.aux = 0; return true; }
    __device__ const char* abase(const Gemm& g, const Unit& u, size_t tstepA) const { return (const char*)g.A + (size_t)u.pm * tstepA; }
    __device__ const char* bbase(const Gemm& g, const Unit& u, size_t tstepB) const { return (const char*)g.Bt + (size_t)u.pn * tstepB; }
    __device__ int ntiles(const Gemm& g, const Unit&) const { return g.K / BK; }
};
struct BranchOrder {
    StaticOrder S;
    __device__ bool next(int i, Unit& u) const { Unit t; const int q = i / 5; if (!S.next(q, t)) return false; u.pm = t.pm; u.pn = t.pn; u.aux = 4 - (i - 5 * q); return true; }
    static __device__ int br(int aux) { return aux - (aux >= 2 ? 1 : 0); }
    __device__ const char* abase(const Gemm& g, const Unit& u, size_t tstepA) const { return (const char*)g.A + (size_t)u.pm * tstepA + (size_t)(512 * br(u.aux) + (u.aux == 2 ? 256 : 0)) * 2; }
    __device__ const char* bbase(const Gemm& g, const Unit& u, size_t tstepB) const { return (const char*)g.Bt + (size_t)u.pn * tstepB + ((size_t)br(u.aux) * 1024 * 512 + (u.aux == 2 ? 256 : 0)) * 2; }
    __device__ int ntiles(const Gemm&, const Unit& u) const { return (u.aux == 1 || u.aux == 2) ? 4 : 8; }
};
typedef f32x4 Acc[2][2][4][2];

template <class Epi, class Sched>
__device__ __forceinline__ void gemm_phase(LAS unsigned char* lds, const Gemm g, const Sched& S, const Epi& E) {
    int tid_ = threadIdx.x; asm volatile("" : "+v"(tid_));
    const int tid = tid_, wid = __builtin_amdgcn_readfirstlane(tid >> 6), lane = tid & 63, wr = wid >> 2, wc = wid & 3, fr = lane & 15, fq = lane >> 4;
    unsigned voffA[2], voffB[2];
#pragma unroll
    for (int i = 0; i < 2; ++i) { int R, C; stage_rc(tid * 16 + i * 8192, R, C); const int Rb = (R & ~31) + perm32(R & 31);
        voffA[i] = (unsigned)(R * g.lda + C) * 2u; voffB[i] = (unsigned)(Rb * g.ldb + C) * 2u; }
    const size_t kstep = (size_t)(BK * 2);
    const size_t hstepA = (size_t)HALF * g.lda * 2, hstepB = (size_t)HALF * g.ldb * 2;
    const size_t tstepA = 2 * hstepA, tstepB = 2 * hstepB;
    const unsigned ldsw = (unsigned)wid * 1024u;
    const int aoff = lds_byte(wr * 64 + fr, fq * 8), boff = lds_byte(wc * 32 + fr, fq * 8);
#define PG8_SA(b, h) (((b) * 2 + (h)) * HTB)
#define PG8_SB(b, h) ((4 + (b) * 2 + (h)) * HTB)
#define PG8_STAGE(bufoff, gbase, voff) do { _Pragma("unroll") for (int _i = 0; _i < 2; ++_i) \
        __builtin_amdgcn_global_load_lds((const unsigned*)((const char*)(gbase) + (voff)[_i]), (LAS unsigned*)(lds + (bufoff) + ldsw + _i * 8192), 16, 0, 0); } while (0)
#define PG8_LDA(dst, b, h) do { _Pragma("unroll") for (int m = 0; m < 4; ++m) _Pragma("unroll") for (int k = 0; k < 2; ++k) dst[m][k] = *(const LAS bf16x8*)(lds + PG8_SA(b, h) + aoff + m * 2048 + k * 1024); } while (0)
#define PG8_LDB(dst, b, h) do { _Pragma("unroll") for (int n = 0; n < 2; ++n) _Pragma("unroll") for (int k = 0; k < 2; ++k) dst[n][k] = *(const LAS bf16x8*)(lds + PG8_SB(b, h) + boff + n * 2048 + k * 1024); } while (0)
#define PG8_MMA(ai, bj, At, Bt) do { __builtin_amdgcn_s_setprio(1); _Pragma("unroll") for (int m = 0; m < 4; ++m) _Pragma("unroll") for (int n = 0; n < 2; ++n) _Pragma("unroll") for (int k = 0; k < 2; ++k) \
        acc[ai][bj][m][n] = __builtin_amdgcn_mfma_f32_16x16x32_bf16(Bt[n][k], At[m][k], acc[ai][bj][m][n], 0, 0, 0); __builtin_amdgcn_s_setprio(0); } while (0)
#define PG8_WAIT_V(n) asm volatile("s_waitcnt vmcnt(" #n ")" ::: "memory")
#define PG8_WAIT_L(n) asm volatile("s_waitcnt lgkmcnt(" #n ")" ::: "memory")
#define PG8_BAR __builtin_amdgcn_s_barrier()
#define PG8_SCHED __builtin_amdgcn_sched_barrier(0)
    Unit cur, nxt; int ui = 0;
    if (!S.next(0, cur)) return;
    Acc acc;
#pragma unroll
    for (int a = 0; a < 2; ++a)
#pragma unroll
        for (int b = 0; b < 2; ++b)
#pragma unroll
            for (int m = 0; m < 4; ++m)
#pragma unroll
                for (int n = 0; n < 2; ++n) acc[a][b][m][n] = (f32x4){0.f, 0.f, 0.f, 0.f};
    bf16x8 At[4][2], B0[2][2], B1[2][2];
    const char* cA = S.abase(g, cur, tstepA); const char* cB = S.bbase(g, cur, tstepB);
    PG8_STAGE(PG8_SB(0, 0), cB, voffB); PG8_STAGE(PG8_SB(0, 1), cB + hstepB, voffB); PG8_STAGE(PG8_SA(0, 0), cA, voffA); PG8_STAGE(PG8_SA(0, 1), cA + hstepA, voffA);
    if (wr == 1) PG8_BAR;
    PG8_WAIT_V(2); PG8_BAR;
    PG8_STAGE(PG8_SB(1, 0), cB + kstep, voffB); PG8_STAGE(PG8_SA(1, 0), cA + kstep, voffA); PG8_STAGE(PG8_SB(1, 1), cB + hstepB + kstep, voffB);
    PG8_WAIT_V(6); PG8_BAR;
    for (;;) {
        const bool has_next = S.next(ui + 1, nxt);
        const char* nA = has_next ? S.abase(g, nxt, tstepA) : cA; const char* nB = has_next ? S.bbase(g, nxt, tstepB) : cB;
        const int nt = S.ntiles(g, cur);
        for (int t = 0; t < nt; t += 2) {
            const bool last = (t == nt - 2);
            const char* a1 = cA + (size_t)(t + 1) * kstep;
            const char* a2 = last ? nA : cA + (size_t)(t + 2) * kstep; const char* b2 = last ? nB : cB + (size_t)(t + 2) * kstep;
            const char* a3 = a2 + kstep; const char* b3 = b2 + kstep;
            PG8_LDB(B0, 0, 0); PG8_LDB(B1, 0, 1); PG8_SCHED; PG8_LDA(At, 0, 0); PG8_STAGE(PG8_SA(1, 1), a1 + hstepA, voffA);
            PG8_WAIT_V(8); PG8_WAIT_L(0); PG8_BAR; PG8_MMA(0, 0, At, B0); PG8_MMA(0, 1, At, B1); PG8_BAR; PG8_SCHED;
            PG8_LDA(At, 0, 1); PG8_STAGE(PG8_SB(0, 0), b2, voffB); PG8_STAGE(PG8_SB(0, 1), b2 + hstepB, voffB); PG8_STAGE(PG8_SA(0, 0), a2, voffA);
            PG8_WAIT_V(8); PG8_WAIT_L(0); PG8_BAR; PG8_MMA(1, 0, At, B0); PG8_MMA(1, 1, At, B1); PG8_BAR; PG8_SCHED;
            PG8_LDB(B0, 1, 0); PG8_LDB(B1, 1, 1); PG8_SCHED; PG8_LDA(At, 1, 0); PG8_STAGE(PG8_SA(0, 1), a2 + hstepA, voffA);
            PG8_WAIT_V(8); PG8_WAIT_L(0); PG8_BAR; PG8_MMA(0, 0, At, B0); PG8_MMA(0, 1, At, B1); PG8_BAR; PG8_SCHED;
            PG8_LDA(At, 1, 1); PG8_STAGE(PG8_SB(1, 0), b3, voffB); PG8_STAGE(PG8_SB(1, 1), b3 + hstepB, voffB); PG8_STAGE(PG8_SA(1, 0), a3, voffA);
            PG8_WAIT_V(8); PG8_WAIT_L(0); PG8_BAR; PG8_MMA(1, 0, At, B0); PG8_MMA(1, 1, At, B1); PG8_BAR; PG8_SCHED;
        }
        if (wr == 0) PG8_BAR;
        E(acc, cur, wr, wc, fr, fq);
        if (!has_next) break;
#pragma unroll
        for (int a = 0; a < 2; ++a)
#pragma unroll
            for (int b = 0; b < 2; ++b)
#pragma unroll
                for (int m = 0; m < 4; ++m)
#pragma unroll
                    for (int n = 0; n < 2; ++n) acc[a][b][m][n] = (f32x4){0.f, 0.f, 0.f, 0.f};
        cur = nxt; cA = nA; cB = nB; ++ui;
        if (wr == 1) PG8_BAR;
    }
    PG8_WAIT_V(0);
    PG8_BAR;
#undef PG8_SA
#undef PG8_SB
#undef PG8_STAGE
#undef PG8_LDA
#undef PG8_LDB
#undef PG8_MMA
#undef PG8_WAIT_V
#undef PG8_WAIT_L
#undef PG8_BAR
#undef PG8_SCHED
}

DI u32x4 ld_agent16(const bf16_t* p) { const unsigned long long* q = (const unsigned long long*)p;
    const unsigned long long a = __hip_atomic_load(q, __ATOMIC_RELAXED, __HIP_MEMORY_SCOPE_AGENT), b = __hip_atomic_load(q + 1, __ATOMIC_RELAXED, __HIP_MEMORY_SCOPE_AGENT);
    return (u32x4){(unsigned)a, (unsigned)(a >> 32), (unsigned)b, (unsigned)(b >> 32)}; }
DI u32x4 pack8(f32x4 v0, f32x4 v1) { u32x4 w; w.x = cvt_pk_bf16(v0[0], v0[1]); w.y = cvt_pk_bf16(v0[2], v0[3]); w.z = cvt_pk_bf16(v1[0], v1[1]); w.w = cvt_pk_bf16(v1[2], v1[3]); return w; }
template <int ACT> struct EpiScale {
    bf16_t* O; int ldc; const float* ss;
    DI void operator()(const Acc& acc, const Unit& u, int wr, int wc, int fr, int fq) const {
        const int row0 = u.pm * BM + wr * 64 + fr, col0 = u.pn * BM + wc * 32 + 8 * fq;
        const int asel = (ACT != 2) ? 0 : ((u.pn < 6 || u.pn == 12 || u.pn == 13) ? 1 : ((u.pn == 6 || u.pn == 7) ? 2 : 0));
#pragma unroll
        for (int ai = 0; ai < 2; ++ai)
#pragma unroll
            for (int m = 0; m < 4; ++m) {
                const int row = row0 + ai * HALF + m * 16; const float rs = rsqrtf(ss[row] * (1.0f / DM) + EPS);
                bf16_t* rowp = O + (size_t)row * ldc + col0;
#pragma unroll
                for (int bj = 0; bj < 2; ++bj) { f32x4 v0, v1;
                    if (ACT == 1) {
                        const float nrs = rs * (-1.4426950408889634f);
                        const f32x4 t0 = acc[ai][bj][m][0] * nrs, t1 = acc[ai][bj][m][1] * nrs;
                        f32x4 e0 = {__builtin_amdgcn_exp2f(t0[0]), __builtin_amdgcn_exp2f(t0[1]), __builtin_amdgcn_exp2f(t0[2]), __builtin_amdgcn_exp2f(t0[3])};
                        f32x4 e1 = {__builtin_amdgcn_exp2f(t1[0]), __builtin_amdgcn_exp2f(t1[1]), __builtin_amdgcn_exp2f(t1[2]), __builtin_amdgcn_exp2f(t1[3])};
                        e0 = e0 + 1.0f; e1 = e1 + 1.0f;
                        v0 = (f32x4){__builtin_amdgcn_rcpf(e0[0]), __builtin_amdgcn_rcpf(e0[1]), __builtin_amdgcn_rcpf(e0[2]), __builtin_amdgcn_rcpf(e0[3])};
                        v1 = (f32x4){__builtin_amdgcn_rcpf(e1[0]), __builtin_amdgcn_rcpf(e1[1]), __builtin_amdgcn_rcpf(e1[2]), __builtin_amdgcn_rcpf(e1[3])};
                    } else { v0 = acc[ai][bj][m][0] * rs; v1 = acc[ai][bj][m][1] * rs; }
                    if (ACT == 2) {
                        if (asel != 0) {
                            f32x4 t0, t1;
                            if (asel == 1) { t0 = v0 * (-1.4426950408889634f); t1 = v1 * (-1.4426950408889634f); }
                            else { t0 = (v0 * v0 * 0.044715f + 1.0f) * v0 * (-1.5957691216057308f * 1.4426950408889634f); t1 = (v1 * v1 * 0.044715f + 1.0f) * v1 * (-1.5957691216057308f * 1.4426950408889634f); }
                            f32x4 e0 = {__builtin_amdgcn_exp2f(t0[0]), __builtin_amdgcn_exp2f(t0[1]), __builtin_amdgcn_exp2f(t0[2]), __builtin_amdgcn_exp2f(t0[3])};
                            f32x4 e1 = {__builtin_amdgcn_exp2f(t1[0]), __builtin_amdgcn_exp2f(t1[1]), __builtin_amdgcn_exp2f(t1[2]), __builtin_amdgcn_exp2f(t1[3])};
                            e0 = e0 + 1.0f; e1 = e1 + 1.0f;
                            v0 = v0 * (f32x4){__builtin_amdgcn_rcpf(e0[0]), __builtin_amdgcn_rcpf(e0[1]), __builtin_amdgcn_rcpf(e0[2]), __builtin_amdgcn_rcpf(e0[3])};
                            v1 = v1 * (f32x4){__builtin_amdgcn_rcpf(e1[0]), __builtin_amdgcn_rcpf(e1[1]), __builtin_amdgcn_rcpf(e1[2]), __builtin_amdgcn_rcpf(e1[3])};
                        }
                    }
                    *(u32x4*)(rowp + bj * HALF) = pack8(v0, v1); }
            }
    }
};
struct EpiBranch {
    const bf16_t* gates; bf16_t* mrg; int ld; const float* ssd;
    DI void operator()(const Acc& acc, const Unit& u, int wr, int wc, int fr, int fq) const {
        const int row0 = u.pm * BM + wr * 64 + fr, col0 = u.pn * BM + wc * 32 + 8 * fq;
        const int n = BranchOrder::br(u.aux); const bool scaled = (n == 1); const int grp = (u.aux == 2) ? 1 : 0;
        const bf16_t* gate = gates + 1024 * n;
#pragma unroll
        for (int ai = 0; ai < 2; ++ai)
#pragma unroll
            for (int m = 0; m < 4; ++m) {
                const int row = row0 + ai * HALF + m * 16; float rs = 1.f;
                if (scaled) { const f32x4 q = *(const f32x4*)(ssd + (size_t)row * 8 + grp * 4); rs = rsqrtf(((q[0] + q[1]) + (q[2] + q[3])) * (1.0f / 256.0f) + EPS); }
#pragma unroll
                for (int bj = 0; bj < 2; ++bj) {
                    const size_t off = (size_t)row * ld + col0 + bj * HALF;
                    const u32x4 gw = *(const u32x4*)(gate + off);
                    f32x4 g0 = {bf_lo(gw.x), bf_hi(gw.x), bf_lo(gw.y), bf_hi(gw.y)}, g1 = {bf_lo(gw.z), bf_hi(gw.z), bf_lo(gw.w), bf_hi(gw.w)};
                    f32x4 v0 = acc[ai][bj][m][0] * g0, v1 = acc[ai][bj][m][1] * g1;
                    if (scaled) { v0 = v0 * rs; v1 = v1 * rs; }
                    if (u.aux != 4) { const u32x4 mw = ld_agent16(mrg + off);
                        v0 += (f32x4){bf_lo(mw.x), bf_hi(mw.x), bf_lo(mw.y), bf_hi(mw.y)}; v1 += (f32x4){bf_lo(mw.z), bf_hi(mw.z), bf_lo(mw.w), bf_hi(mw.w)}; }
                    *(u32x4*)(mrg + off) = pack8(v0, v1);
                }
            }
    }
};
struct EpiResid {
    const float* src32; float* dst32; bf16_t* hb; float* ssn;
    DI void operator()(const Acc& acc, const Unit& u, int wr, int wc, int fr, int fq) const {
        const int row0 = u.pm * BM + wr * 64 + fr, col0 = u.pn * BM + wc * 32 + 8 * fq;
#pragma unroll
        for (int ai = 0; ai < 2; ++ai)
#pragma unroll
            for (int m = 0; m < 4; ++m) {
                const int row = row0 + ai * HALF + m * 16; float s = 0.f;
#pragma unroll
                for (int bj = 0; bj < 2; ++bj) {
                    const size_t off = (size_t)row * DM + col0 + bj * HALF;
                    f32x4 r0, r1;
                    if (src32) { r0 = *(const f32x4*)(src32 + off); r1 = *(const f32x4*)(src32 + off + 4); }
                    else { const u32x4 w = *(const u32x4*)(hb + off); r0 = (f32x4){bf_lo(w.x), bf_hi(w.x), bf_lo(w.y), bf_hi(w.y)}; r1 = (f32x4){bf_lo(w.z), bf_hi(w.z), bf_lo(w.w), bf_hi(w.w)}; }
                    const f32x4 v0 = acc[ai][bj][m][0] + r0, v1 = acc[ai][bj][m][1] + r1;
                    if (dst32) { *(f32x4*)(dst32 + off) = v0; *(f32x4*)(dst32 + off + 4) = v1; }
                    else *(u32x4*)(hb + off) = pack8(v0, v1);
                    s += (v0[0] * v0[0] + v0[1] * v0[1]) + (v0[2] * v0[2] + v0[3] * v0[3]) + (v1[0] * v1[0] + v1[1] * v1[1]) + (v1[2] * v1[2] + v1[3] * v1[3]);
                }
                s += __shfl_xor(s, 16); s += __shfl_xor(s, 32);
                if (fq == 0) ssn[(size_t)row * 16 + u.pn * 4 + wc] = s;
            }
    }
};
struct EpiSwiglu {
    bf16_t* O; int ldo; const float* ss;
    DI void operator()(const Acc& acc, const Unit& u, int wr, int wc, int fr, int fq) const {
        const int row0 = u.pm * BM + wr * 64 + fr, col0 = u.pn * HALF + wc * 32 + 8 * fq;
#pragma unroll
        for (int ai = 0; ai < 2; ++ai)
#pragma unroll
            for (int m = 0; m < 4; ++m) {
                const int row = row0 + ai * HALF + m * 16; const float rs = rsqrtf(ss[row] * (1.0f / DM) + EPS);
                const float nrs = rs * (-1.4426950408889634f), rs2 = rs * rs;
                const f32x4 g0 = acc[ai][0][m][0], g1 = acc[ai][0][m][1];
                const f32x4 t0 = g0 * nrs, t1 = g1 * nrs;
                f32x4 e0 = {__builtin_amdgcn_exp2f(t0[0]), __builtin_amdgcn_exp2f(t0[1]), __builtin_amdgcn_exp2f(t0[2]), __builtin_amdgcn_exp2f(t0[3])};
                f32x4 e1 = {__builtin_amdgcn_exp2f(t1[0]), __builtin_amdgcn_exp2f(t1[1]), __builtin_amdgcn_exp2f(t1[2]), __builtin_amdgcn_exp2f(t1[3])};
                e0 = e0 + 1.0f; e1 = e1 + 1.0f;
                const f32x4 r0 = {__builtin_amdgcn_rcpf(e0[0]), __builtin_amdgcn_rcpf(e0[1]), __builtin_amdgcn_rcpf(e0[2]), __builtin_amdgcn_rcpf(e0[3])};
                const f32x4 r1 = {__builtin_amdgcn_rcpf(e1[0]), __builtin_amdgcn_rcpf(e1[1]), __builtin_amdgcn_rcpf(e1[2]), __builtin_amdgcn_rcpf(e1[3])};
                const f32x4 v0 = ((g0 * acc[ai][1][m][0]) * rs2) * r0, v1 = ((g1 * acc[ai][1][m][1]) * rs2) * r1;
                *(u32x4*)(O + (size_t)row * ldo + col0) = pack8(v0, v1);
            }
    }
};
}

struct Args {
    const float* in[27];
    float* out; unsigned char* ws; long long pad;
};
struct Ctx { LAS unsigned char* lds; float* out; unsigned char* ws;
    DI const float* in(int i) const { return *(const float* const LAS*)(lds + PTAB_OFF + 8 * i); } };
enum { I_X = 0, I_NMIX, I_WIN, I_HLB, I_HNW, I_SCW, I_SCB, I_SDTB, I_SALOG, I_SD, I_SNW, I_GGW, I_GGB, I_GNW, I_LCW, I_LCB, I_LWA, I_LBA, I_LWX, I_LBX, I_LLAM,
       I_WBR, I_WOUT, I_NFFN, I_WFIN, I_WFOUT, I_NF };

DI int mix_src(int n) {
    if (n < 512) return n;
    if (n < 1024) return 2048 + (n - 512);
    if (n < 1536) return 4360 + (n - 1024);
    if (n < 2048) return 5400 + (n - 1536);
    if (n < 2560) return 512 + (n - 2048);
    if (n < 3072) return 1024 + (n - 2560);
    if (n < 3584) return 1536 + (n - 3072);
    if (n < 4352) return 2560 + (n - 3584);
    if (n < 4360) return 3328 + (n - 4352);
    if (n < 4376) return 4872 + (n - 4360);
    if (n < 4384) return -1;
    if (n < 4640) return 3336 + (n - 4384);
    if (n < 4896) return 3592 + (n - 4640);
    if (n < 5408) return 3848 + (n - 4896);
    if (n < 5920) return 4888 + (n - 5408);
    return -1;
}
struct WJob { const float* W; bf16_t* WT; const float* scale; int ldw, ldt, k0, n0, mode, soff; };
DI int wsrc(const WJob& j, int np) {
    if (j.mode == 0) return np + j.soff;
    if (j.mode == 1) return mix_src(np);
    const int pn = np >> 8, bj = (np >> 7) & 1, q = np & 127; return bj * DFF + 128 * pn + q;
}
constexpr int WT_MIX = 16 * 24, WT_GATE = 16 * 16, WT_BR1 = 8 * 4, WT_OUT = 16 * 4, WT_FIN = 16 * 22, WT_FOUT = 44 * 4;
constexpr int WT_PER_L = WT_MIX + WT_GATE + 4 * WT_BR1 + WT_OUT + WT_FIN + WT_FOUT;
DI void wjob_decode(const Ctx& a, int it, WJob& j) {
    const int l = it / WT_PER_L; int r = it % WT_PER_L;
    unsigned char* wl = a.ws + OFF_W + (size_t)l * W_LAYER;
    const float* win = a.in(I_WIN) + (size_t)l * DM * W_IN_N;
    j.soff = 0; j.mode = 0; j.scale = nullptr;
    if (r < WT_MIX) { j.W = win; j.ldw = W_IN_N; j.WT = (bf16_t*)(wl + WO_MIX); j.ldt = DM; j.k0 = 64 * (r / 24); j.n0 = 256 * (r % 24); j.mode = 1; j.scale = a.in(I_NMIX) + l * DM; return; } r -= WT_MIX;
    if (r < WT_GATE) { j.W = win; j.ldw = W_IN_N; j.WT = (bf16_t*)(wl + WO_GATE); j.ldt = DM; j.k0 = 64 * (r / 16); j.n0 = 256 * (r % 16); j.soff = 5912; j.scale = a.in(I_NMIX) + l * DM; return; } r -= WT_GATE;
    if (r < 4 * WT_BR1) { const int n = r / WT_BR1, q = r % WT_BR1; j.W = a.in(I_WBR) + ((size_t)l * 4 + n) * 512 * DM; j.ldw = DM; j.WT = (bf16_t*)(wl + WO_BR) + (size_t)n * DM * 512; j.ldt = 512;
        j.k0 = 64 * (q / 4); j.n0 = 256 * (q % 4); j.scale = (n == 1) ? a.in(I_SNW) + l * 512 : nullptr; return; } r -= 4 * WT_BR1;
    if (r < WT_OUT) { j.W = a.in(I_WOUT) + (size_t)l * DM * DM; j.ldw = DM; j.WT = (bf16_t*)(wl + WO_OUT); j.ldt = DM; j.k0 = 64 * (r / 4); j.n0 = 256 * (r % 4); return; } r -= WT_OUT;
    if (r < WT_FIN) { j.W = a.in(I_WFIN) + (size_t)l * DM * 2 * DFF; j.ldw = 2 * DFF; j.WT = (bf16_t*)(wl + WO_FIN); j.ldt = DM; j.k0 = 64 * (r / 22); j.n0 = 256 * (r % 22); j.mode = 2; j.scale = a.in(I_NFFN) + l * DM; return; } r -= WT_FIN;
    j.W = a.in(I_WFOUT) + (size_t)l * DFF * DM; j.ldw = DM; j.WT = (bf16_t*)(wl + WO_FOUT); j.ldt = DFF; j.k0 = 64 * (r / 4); j.n0 = 256 * (r % 4);
}
DI void wjob_issue(const WJob& j, int tid, f32x4 (&regs)[8]) {
#pragma unroll
    for (int q = 0; q < 8; ++q) { const int idx = tid + 512 * q, kr = idx >> 6, n4 = idx & 63; const int src = wsrc(j, j.n0 + 4 * n4);
        regs[q] = (src >= 0) ? *(const f32x4*)(j.W + (size_t)(j.k0 + kr) * j.ldw + src) : (f32x4){0.f, 0.f, 0.f, 0.f}; }
}
#define BAR_LDS() do { asm volatile("s_waitcnt lgkmcnt(0)" ::: "memory"); __builtin_amdgcn_s_barrier(); asm volatile("" ::: "memory"); } while (0)

template <bool QUEUE>
DI void convert_weights(const Ctx& a, LAS unsigned char* lds, int tid, int first, int tend, int step, unsigned* wq) {
    LAS float* T = (LAS float*)lds;
    volatile LAS int* tick = (volatile LAS int*)(lds + 64 * 257 * 4 + 64);
    f32x4 regs[8]; WJob job, nj;
    int it = first;
    if (QUEUE) { if (tid == 0) tick[0] = first + (int)__hip_atomic_fetch_add(wq, 1u, __ATOMIC_RELAXED, __HIP_MEMORY_SCOPE_AGENT); BAR_LDS(); it = tick[0]; BAR_LDS(); }
    if (it < tend) { wjob_decode(a, it, job); wjob_issue(job, tid, regs); }
    while (it < tend) {
#pragma unroll
        for (int q = 0; q < 8; ++q) { const int idx = tid + 512 * q, kr = idx >> 6, n4 = idx & 63; LAS float* d = T + kr * 257 + 4 * n4;
            d[0] = regs[q][0]; d[1] = regs[q][1]; d[2] = regs[q][2]; d[3] = regs[q][3]; }
        if (QUEUE) { if (tid == 0) tick[0] = first + (int)__hip_atomic_fetch_add(wq, 1u, __ATOMIC_RELAXED, __HIP_MEMORY_SCOPE_AGENT); }
        BAR_LDS();
        const int nit = QUEUE ? tick[0] : it + step;
        if (nit < tend) { wjob_decode(a, nit, nj); wjob_issue(nj, tid, regs); }
        const int c = tid & 7;
        float sc[8];
#pragma unroll
        for (int i = 0; i < 8; ++i) sc[i] = job.scale ? job.scale[job.k0 + 8 * c + i] : 1.f;
#pragma unroll
        for (int q = 0; q < 4; ++q) { const int n = (tid + 512 * q) >> 3; const LAS float* sp = T + (8 * c) * 257 + n;
            u32x4 o; o.x = cvt_pk_bf16(sp[0 * 257] * sc[0], sp[1 * 257] * sc[1]); o.y = cvt_pk_bf16(sp[2 * 257] * sc[2], sp[3 * 257] * sc[3]);
            o.z = cvt_pk_bf16(sp[4 * 257] * sc[4], sp[5 * 257] * sc[5]); o.w = cvt_pk_bf16(sp[6 * 257] * sc[6], sp[7 * 257] * sc[7]);
            *(u32x4*)(job.WT + (size_t)(job.n0 + n) * job.ldt + job.k0 + 8 * c) = o; }
        BAR_LDS();
        job = nj; it = nit;
    }
}

DI void phase_prologue(const Ctx& a, LAS unsigned char* lds, int G) {
    int tid_ = threadIdx.x; asm volatile("" : "+v"(tid_));
    const int tid = tid_, lane = tid & 63, wave = tid >> 6;
    const int gw = blockIdx.x * 8 + wave, NGW = G * 8;
    float* ss = (float*)(a.ws + OFF_SS);
    convert_weights<false>(a, lds, tid, blockIdx.x, WT_MIX, G, nullptr);
    bf16_t* hb = (bf16_t*)(a.ws + OFF_HBF);
    for (int m = 2 * gw; m < MT; m += 2 * NGW) {
        f32x4 v[2][4];
#pragma unroll
        for (int r = 0; r < 2; ++r) { const f32x4* xr = (const f32x4*)(a.in(I_X) + (size_t)(m + r) * DM) + lane;
#pragma unroll
            for (int j = 0; j < 4; ++j) v[r][j] = xr[64 * j]; }
#pragma unroll
        for (int r = 0; r < 2; ++r) { u32x2* hrow = (u32x2*)(hb + (size_t)(m + r) * DM) + lane; float sq = 0.f;
#pragma unroll
            for (int j = 0; j < 4; ++j) { const f32x4 t = v[r][j]; sq += (t[0] * t[0] + t[1] * t[1]) + (t[2] * t[2] + t[3] * t[3]);
                u32x2 w; w.x = cvt_pk_bf16(t[0], t[1]); w.y = cvt_pk_bf16(t[2], t[3]); hrow[64 * j] = w; }
            sq = wave_sum(sq);
            if (lane == 0) ss[m + r] = sq; }
    }
}

DI f32x16 mma_nt(const LAS bf16_t* A, int lda, int m0, const LAS bf16_t* B, int ldb, int n0, int K, f32x16 acc, int lane) {
    const int r = lane & 31, h = lane >> 5;
    const LAS bf16_t* ap = A + (m0 + r) * lda + 8 * h; const LAS bf16_t* bp = B + (n0 + r) * ldb + 8 * h;
    for (int ks = 0; ks < K; ks += 16) {
        const bf16x8 av = *(const LAS bf16x8*)(ap + ks), bv = *(const LAS bf16x8*)(bp + ks);
        acc = __builtin_amdgcn_mfma_f32_32x32x16_bf16(av, bv, acc, 0, 0, 0);
    }
    return acc;
}
DI int crow(int reg, int h) { return (reg & 3) + 8 * (reg >> 2) + 4 * h; }
#define ZERO16(x) do { _Pragma("unroll") for (int _z = 0; _z < 16; ++_z) (x)[_z] = 0.f; } while (0)

template <int DK, bool HG>
DI void mixer_gla(const Ctx& a, LAS unsigned char* lds, int l, int b, int hd) {
    constexpr int LQ = DK + 8, LT = 72;
    int tid_ = threadIdx.x; asm volatile("" : "+v"(tid_));
    const int tid = tid_, lane = tid & 63, w = __builtin_amdgcn_readfirstlane(tid >> 6), r32 = lane & 31, hh = lane >> 5;
    bf16_t* proj = (bf16_t*)(a.ws + OFF_PROJ);
    LAS bf16_t* Qs = (LAS bf16_t*)lds;
    LAS bf16_t* Ks = Qs + 64 * LQ;
    LAS float* Os = (LAS float*)lds;
    LAS bf16_t* Q2s = Ks + 64 * LQ;
    LAS bf16_t* KTs = Q2s + 64 * LQ;
    LAS bf16_t* VTs = KTs + DK * LT;
    LAS bf16_t* Ps = VTs + 128 * LT;
    LAS bf16_t* STs = Ps + 64 * LT;
    LAS float* part = (LAS float*)(STs + 128 * LQ);
    LAS float* e1s = part + 8 * DK;
    LAS float* e2s = e1s + DK;
    LAS bf16_t* GLs = (LAS bf16_t*)(e2s + DK);
    constexpr int NST = DK / 64;
    f32x16 S[NST];
#pragma unroll
    for (int s = 0; s < NST; ++s) ZERO16(S[s]);
    for (int i = tid; i < 128 * LQ / 2; i += 512) ((LAS unsigned*)STs)[i] = 0u;
    const int cq = HG ? C_HQ + hd * 128 : C_GQ + hd * 64;
    const int cf = HG ? C_HF + hd * 128 : C_GK + hd * 64;
    const int cv = HG ? C_HI + hd * 128 : C_GV + hd * 128;
    const int cg_ = HG ? C_HG + hd * 128 : C_GG + hd * 128;
    const int cout_ = HG ? C_HQ + hd * 128 : C_GG + hd * 128;
    float lb0 = 0.f, lb1 = 0.f;
    float gw_[16]; float gb_ = 0.f;
    if (HG) {
        if (l > 0) { const float* p = a.in(I_HLB); const int c0 = hd * 128 + 2 * lane;
            lb0 = 1.f / (1.f + __expf(p[c0] - p[512 + c0])); lb1 = 1.f / (1.f + __expf(p[c0 + 1] - p[512 + c0 + 1])); }
#pragma unroll
        for (int i = 0; i < 16; ++i) gw_[i] = 0.f;
    } else {
#pragma unroll
        for (int i = 0; i < 16; ++i) gw_[i] = a.in(I_GGW)[((size_t)l * 16 + i) * 256 + hd * 64 + lane];
        gb_ = a.in(I_GGB)[l * 256 + hd * 64 + lane];
    }
    const float* nw = (HG ? a.in(I_HNW) : a.in(I_GNW)) + l * 128;
    const int e8 = tid & 7;
    unsigned pq[8], pf[8], pv[8]; u32x4 pgl = {0u, 0u, 0u, 0u};
    const size_t rowb = (size_t)b * SEQ;
#define GLA_PREFETCH(cn) do { const size_t r0_ = rowb + 64 * (cn); \
        _Pragma("unroll") for (int t = 0; t < 8; ++t) { const bf16_t* rp = proj + (r0_ + 8 * w + t) * PLD; \
            if (HG) { pq[t] = *(const unsigned*)(rp + cq + 2 * lane); pf[t] = *(const unsigned*)(rp + cf + 2 * lane); } \
            else { pq[t] = rp[cq + lane]; pf[t] = rp[cf + lane]; } \
            pv[t] = *(const unsigned*)(rp + cv + 2 * lane); } \
        if (!HG && tid < 128) pgl = *(const u32x4*)(proj + (r0_ + (tid >> 1)) * PLD + C_GLR + 8 * (tid & 1)); } while (0)
    GLA_PREFETCH(0);
    if (!HG && tid < 128) *(LAS u32x4*)(GLs + (tid >> 1) * 16 + 8 * (tid & 1)) = pgl;
    __syncthreads();

    for (int c = 0; c < SEQ / 64; ++c) {
        const size_t row0 = rowb + 64 * c;
        bf16_t* rpd = proj + (row0 + (tid >> 3)) * PLD;
        float lf[8][2], qv[8][2], kv[8][2]; unsigned vv[8];
        f32v2_t fV[8], qV[8], kV[8];
        if (HG) {
            const f32v2_t lbv = {lb0, lb1}, omlb = {1.f - lb0, 1.f - lb1};
#pragma unroll
            for (int t = 0; t < 8; ++t) {
                const unsigned q2 = pq[t], f2 = pf[t]; vv[t] = pv[t];
                const f32v2_t fx = {bf_lo(f2), bf_hi(f2)};
                const f32v2_t ex = fx * (-1.4426950408889634f);
                f32v2_t en = {__builtin_amdgcn_exp2f(ex[0]), __builtin_amdgcn_exp2f(ex[1])};
                en = en + 1.0f;
                const f32v2_t sg = {__builtin_amdgcn_rcpf(en[0]), __builtin_amdgcn_rcpf(en[1])};
                const f32v2_t f = omlb * sg + lbv;
                fV[t] = f; kV[t] = 1.0f - f;
                qV[t] = (f32v2_t){bf_lo(q2), bf_hi(q2)};
            }
            f32v2_t sp = fV[0];
#pragma unroll
            for (int t = 1; t < 8; ++t) sp = sp * fV[t];
            part[w * DK + 2 * lane] = __logf(fmaxf(sp[0], 1.2e-37f)); part[w * DK + 2 * lane + 1] = __logf(fmaxf(sp[1], 1.2e-37f));
        } else {
#pragma unroll
            for (int t = 0; t < 8; ++t) {
                vv[t] = pv[t];
                qv[t][0] = bf1((bf16_t)pq[t]) * 0.125f; kv[t][0] = bf1((bf16_t)pf[t]); qv[t][1] = 0.f; kv[t][1] = 0.f;
                const u32x4 g0 = *(const LAS u32x4*)(GLs + (8 * w + t) * 16), g1 = *(const LAS u32x4*)(GLs + (8 * w + t) * 16 + 8);
                float d = gb_;
                d += bf_lo(g0.x) * gw_[0] + bf_hi(g0.x) * gw_[1] + bf_lo(g0.y) * gw_[2] + bf_hi(g0.y) * gw_[3] + bf_lo(g0.z) * gw_[4] + bf_hi(g0.z) * gw_[5] + bf_lo(g0.w) * gw_[6] + bf_hi(g0.w) * gw_[7];
                d += bf_lo(g1.x) * gw_[8] + bf_hi(g1.x) * gw_[9] + bf_lo(g1.y) * gw_[10] + bf_hi(g1.y) * gw_[11] + bf_lo(g1.z) * gw_[12] + bf_hi(g1.z) * gw_[13] + bf_lo(g1.w) * gw_[14] + bf_hi(g1.w) * gw_[15];
                lf[t][0] = -softplus_fast(-d) * (1.0f / 16.0f); lf[t][1] = 0.f;
            }
            float s0 = 0.f;
#pragma unroll
            for (int t = 0; t < 8; ++t) s0 += lf[t][0];
            part[w * DK + lane] = s0;
        }
        const u32x4 ga = *(const u32x4*)(rpd + cg_ + 16 * e8), gb2 = *(const u32x4*)(rpd + cg_ + 16 * e8 + 8);
        if (c + 1 < SEQ / 64) GLA_PREFETCH(c + 1);
        BAR_LDS();
        if (HG) {
            float offs[2], br[2], bl[2];
#pragma unroll
            for (int cc = 0; cc < 2; ++cc) { const int d = 2 * lane + cc; offs[cc] = 0.f; br[cc] = 0.f; bl[cc] = 0.f;
#pragma unroll
                for (int ww = 0; ww < 8; ++ww) { const float pvv = part[ww * DK + d]; if (ww < w) offs[cc] += pvv; if (ww < 4) br[cc] += pvv; bl[cc] += pvv; }
                if (w == 0) { e1s[d] = __expf(clampe(bl[cc])); e2s[d] = __expf(clampe(bl[cc] - br[cc])); } }
            f32v2_t bc = {__expf(clampe(offs[0] - br[0])), __expf(clampe(offs[1] - br[1]))}; unsigned kt0[4], kt1[4];
            const f32v2_t ebr = {__expf(fmaxf(br[0], -87.f)), __expf(fmaxf(br[1], -87.f))};
#pragma unroll
            for (int t = 0; t < 8; ++t) {
                bc = bc * fV[t];
                bc = (f32v2_t){fmaxf(bc[0], 1.2e-37f), fmaxf(bc[1], 1.2e-37f)};
                const f32v2_t qa = qV[t] * bc;
                const f32v2_t q2 = qa * ebr;
                const f32v2_t rc = {__builtin_amdgcn_rcpf(bc[0]), __builtin_amdgcn_rcpf(bc[1])};
                const f32v2_t ka = kV[t] * rc;
                *(LAS unsigned*)(Qs + (8 * w + t) * LQ + 2 * lane) = cvt_pk_bf16(qa[0], qa[1]);
                *(LAS unsigned*)(Q2s + (8 * w + t) * LQ + 2 * lane) = cvt_pk_bf16(q2[0], q2[1]);
                const unsigned kp = cvt_pk_bf16(ka[0], ka[1]);
                *(LAS unsigned*)(Ks + (8 * w + t) * LQ + 2 * lane) = kp;
                if (t & 1) { kt0[t >> 1] |= kp << 16; kt1[t >> 1] |= kp & 0xffff0000u; } else { kt0[t >> 1] = kp & 0xffffu; kt1[t >> 1] = kp >> 16; }
            }
            *(LAS u32x4*)(KTs + (2 * lane) * LT + 8 * w) = (u32x4){kt0[0], kt0[1], kt0[2], kt0[3]};
            *(LAS u32x4*)(KTs + (2 * lane + 1) * LT + 8 * w) = (u32x4){kt1[0], kt1[1], kt1[2], kt1[3]};
        } else {
            const int d = lane;
            float offs = 0.f, br = 0.f, bl = 0.f;
#pragma unroll
            for (int ww = 0; ww < 8; ++ww) { const float pvv = part[ww * DK + d]; if (ww < w) offs += pvv; if (ww < 4) br += pvv; bl += pvv; }
            if (w == 0) { e1s[d] = __expf(clampe(bl)); e2s[d] = __expf(clampe(bl - br)); }
            float bc = offs; unsigned ktp[4];
            const float ebr = __expf(fmaxf(br, -87.f));
#pragma unroll
            for (int t = 0; t < 8; ++t) {
                bc += lf[t][0];
                const float e1_ = __expf(clampe(bc - br)); const float q1 = qv[t][0] * e1_, q2 = q1 * ebr, k1 = kv[t][0] * __builtin_amdgcn_rcpf(e1_);
                const unsigned qq = cvt_pk_bf16(q1, q2), kk = cvt_pk_bf16(k1, 0.f);
                Qs[(8 * w + t) * LQ + d] = (bf16_t)(qq & 0xffffu); Q2s[(8 * w + t) * LQ + d] = (bf16_t)(qq >> 16); Ks[(8 * w + t) * LQ + d] = (bf16_t)(kk & 0xffffu);
                if (t & 1) ktp[t >> 1] |= kk << 16; else ktp[t >> 1] = kk & 0xffffu;
            }
            *(LAS u32x4*)(KTs + d * LT + 8 * w) = (u32x4){ktp[0], ktp[1], ktp[2], ktp[3]};
        }
        {
            u32x4 v0, v1;
            v0.x = (vv[0] & 0xffffu) | (vv[1] << 16); v0.y = (vv[2] & 0xffffu) | (vv[3] << 16); v0.z = (vv[4] & 0xffffu) | (vv[5] << 16); v0.w = (vv[6] & 0xffffu) | (vv[7] << 16);
            v1.x = (vv[0] >> 16) | (vv[1] & 0xffff0000u); v1.y = (vv[2] >> 16) | (vv[3] & 0xffff0000u); v1.z = (vv[4] >> 16) | (vv[5] & 0xffff0000u); v1.w = (vv[6] >> 16) | (vv[7] & 0xffff0000u);
            *(LAS u32x4*)(VTs + (2 * lane) * LT + 8 * w) = v0; *(LAS u32x4*)(VTs + (2 * lane + 1) * LT + 8 * w) = v1;
        }
        BAR_LDS();
        if (w < 4) {
            const int jt = w >> 1, it = w & 1;
            f32x16 sc; ZERO16(sc);
            if (it >= jt) sc = mma_nt(Ks, LQ, 32 * jt, Qs, LQ, 32 * it, DK, sc, lane);
            const int i = 32 * it + r32;
#pragma unroll
            for (int g = 0; g < 4; ++g) {
                const int j0 = 32 * jt + 8 * g + 4 * hh;
                float p0 = (i >= j0) ? sc[4 * g] : 0.f, p1 = (i >= j0 + 1) ? sc[4 * g + 1] : 0.f, p2 = (i >= j0 + 2) ? sc[4 * g + 2] : 0.f, p3 = (i >= j0 + 3) ? sc[4 * g + 3] : 0.f;
                *(LAS u32x2*)(Ps + i * LT + j0) = (u32x2){cvt_pk_bf16(p0, p1), cvt_pk_bf16(p2, p3)};
            }
        }
        const int oit = w >> 2, ovt = w & 3;
        f32x16 oacc; ZERO16(oacc);
        oacc = mma_nt(Q2s, LQ, 32 * oit, STs, LQ, 32 * ovt, DK, oacc, lane);
#pragma unroll
        for (int s = 0; s < NST; ++s) {
            const int q = NST * w + s, dt = q >> 2, vt = q & 3;
            f32x16 tmp; ZERO16(tmp);
            tmp = mma_nt(KTs, LT, 32 * dt, VTs, LT, 32 * vt, 64, tmp, lane);
#pragma unroll
            for (int g = 0; g < 4; ++g) {
                const f32x4 x1 = *(const LAS f32x4*)(e1s + 32 * dt + 8 * g + 4 * hh), x2 = *(const LAS f32x4*)(e2s + 32 * dt + 8 * g + 4 * hh);
                { const f32x4 so = {S[s][4 * g], S[s][4 * g + 1], S[s][4 * g + 2], S[s][4 * g + 3]}, tv = {tmp[4 * g], tmp[4 * g + 1], tmp[4 * g + 2], tmp[4 * g + 3]};
                  const f32x4 sn = x1 * so + x2 * tv; S[s][4 * g] = sn[0]; S[s][4 * g + 1] = sn[1]; S[s][4 * g + 2] = sn[2]; S[s][4 * g + 3] = sn[3]; }
            }
        }
        BAR_LDS();
        oacc = mma_nt(Ps, LT, 32 * oit, VTs, LT, 32 * ovt, 64, oacc, lane);
#pragma unroll
        for (int rg = 0; rg < 16; ++rg) Os[(32 * oit + crow(rg, hh)) * 132 + 32 * ovt + r32] = oacc[rg];
#pragma unroll
        for (int s = 0; s < NST; ++s) {
            const int q = NST * w + s, dt = q >> 2, vt = q & 3;
#pragma unroll
            for (int g = 0; g < 4; ++g)
                *(LAS u32x2*)(STs + (32 * vt + r32) * LQ + 32 * dt + 8 * g + 4 * hh) = (u32x2){cvt_pk_bf16(S[s][4 * g], S[s][4 * g + 1]), cvt_pk_bf16(S[s][4 * g + 2], S[s][4 * g + 3])};
        }
        if (!HG && tid < 128 && c + 1 < SEQ / 64) *(LAS u32x4*)(GLs + (tid >> 1) * 16 + 8 * (tid & 1)) = pgl;
        BAR_LDS();
        {
            const int i = tid >> 3;
            const LAS f32x4* op = (const LAS f32x4*)(Os + i * 132 + 16 * e8);
            f32x4 o[4]; float ssq = 0.f;
#pragma unroll
            for (int j = 0; j < 4; ++j) { o[j] = op[j]; ssq += (o[j][0] * o[j][0] + o[j][1] * o[j][1]) + (o[j][2] * o[j][2] + o[j][3] * o[j][3]); }
            ssq += __shfl_xor(ssq, 1); ssq += __shfl_xor(ssq, 2); ssq += __shfl_xor(ssq, 4);
            const float rs = rsqrtf(ssq * (1.0f / 128.0f) + EPS);
            const unsigned gu[8] = {ga.x, ga.y, ga.z, ga.w, gb2.x, gb2.y, gb2.z, gb2.w};
            float nwr[16];
#pragma unroll
            for (int q = 0; q < 4; ++q) { const f32x4 t4 = *(const f32x4*)(nw + 16 * e8 + 4 * q); nwr[4 * q] = t4[0]; nwr[4 * q + 1] = t4[1]; nwr[4 * q + 2] = t4[2]; nwr[4 * q + 3] = t4[3]; }
            unsigned ou[8];
#pragma unroll
            for (int j = 0; j < 8; ++j) {
                const f32v2_t ov = {o[j >> 1][(2 * j) & 3], o[j >> 1][(2 * j + 1) & 3]}, nv = {nwr[2 * j], nwr[2 * j + 1]}, gv = {bf_lo(gu[j]), bf_hi(gu[j])};
                const f32v2_t yv = (ov * rs) * (nv * gv);
                ou[j] = cvt_pk_bf16(yv[0], yv[1]);
            }
            *(u32x4*)(rpd + cout_ + 16 * e8) = (u32x4){ou[0], ou[1], ou[2], ou[3]}; *(u32x4*)(rpd + cout_ + 16 * e8 + 8) = (u32x4){ou[4], ou[5], ou[6], ou[7]};
        }
    }
#undef GLA_PREFETCH
    __syncthreads();
}

DI void mixer_ssd(const Ctx& a, LAS unsigned char* lds, int l, int b, int hd) {
    constexpr int LT = 72;
    int tid_ = threadIdx.x; asm volatile("" : "+v"(tid_));
    const int tid = tid_, lane = tid & 63, w = __builtin_amdgcn_readfirstlane(tid >> 6), r32 = lane & 31, hh = lane >> 5;
    const int grp = hd >> 2;
    bf16_t* proj = (bf16_t*)(a.ws + OFF_PROJ);
    float* ssd = (float*)(a.ws + OFF_SSD);
    LAS bf16_t* Bs = (LAS bf16_t*)lds;
    LAS bf16_t* Cs = Bs + 64 * LT;
    LAS bf16_t* BTs = Cs + 64 * LT;
    LAS bf16_t* XTs = BTs + 64 * LT;
    LAS bf16_t* XWs = XTs + 64 * LT;
    LAS bf16_t* Xb = XWs + 64 * LT;
    LAS bf16_t* Ps = Xb + 64 * LT;
    LAS bf16_t* Ss = Ps + 64 * LT;
    LAS float* Os = (LAS float*)(Ss + 64 * LT);
    LAS float* dts = Os + 64 * 68;
    LAS float* acs = dts + 64;
    LAS float* Xs32 = acs + 64;
    LAS float* eacs = Xs32 + 64 * 66;
    LAS float* wts = eacs + 64;
    f32x16 S; ZERO16(S);
    for (int i = tid; i < 64 * LT / 2; i += 512) ((LAS unsigned*)Ss)[i] = 0u;
    const int arr = tid >> 7, pr = tid & 31, tg = (tid & 127) >> 5;
    int ccol = 0;
    if (arr == 0) ccol = hd * 64 + 2 * pr; else if (arr == 1) ccol = 512 + grp * 64 + 2 * pr; else ccol = 640 + grp * 64 + 2 * pr;
    float cw[4][2], cb[2];
    if (arr < 3) {
#pragma unroll
        for (int k = 0; k < 4; ++k) { cw[k][0] = a.in(I_SCW)[((size_t)l * 4 + k) * 768 + ccol]; cw[k][1] = a.in(I_SCW)[((size_t)l * 4 + k) * 768 + ccol + 1]; }
        cb[0] = a.in(I_SCB)[l * 768 + ccol]; cb[1] = a.in(I_SCB)[l * 768 + ccol + 1];
    } else {
#pragma unroll
        for (int k = 0; k < 4; ++k) { cw[k][0] = 0.f; cw[k][1] = 0.f; }
        cb[0] = cb[1] = 0.f;
    }
    const float dtb = a.in(I_SDTB)[l * 8 + hd], aneg = -__expf(a.in(I_SALOG)[l * 8 + hd]), dsk = a.in(I_SD)[l * 8 + hd];
    const size_t rowb = (size_t)b * SEQ;
    unsigned pwin[19]; unsigned pdr = 0u;
#define SSD_PREFETCH(cn) do { if (arr < 3) { _Pragma("unroll") for (int t = 0; t < 19; ++t) { const int tt = 64 * (cn) + 16 * tg + t - 3; \
            pwin[t] = (tt >= 0) ? *(const unsigned*)(proj + (rowb + tt) * PLD + C_XBC + ccol) : 0u; } } \
        else if (w == 6) pdr = proj[(rowb + 64 * (cn) + lane) * PLD + C_DT + hd]; } while (0)
    SSD_PREFETCH(0);
    __syncthreads();
    for (int c = 0; c < SEQ / 64; ++c) {
        const size_t row0 = rowb + 64 * c;
        bf16_t* rpd = proj + (row0 + (tid >> 3)) * PLD + C_SZ + hd * 64 + 8 * (tid & 7);
        float xs[16][2];
        if (arr < 3) {
#pragma unroll
            for (int t = 0; t < 16; ++t) {
                const float y0 = cb[0] + cw[0][0] * bf_lo(pwin[t]) + cw[1][0] * bf_lo(pwin[t + 1]) + cw[2][0] * bf_lo(pwin[t + 2]) + cw[3][0] * bf_lo(pwin[t + 3]);
                const float y1 = cb[1] + cw[0][1] * bf_hi(pwin[t]) + cw[1][1] * bf_hi(pwin[t + 1]) + cw[2][1] * bf_hi(pwin[t + 2]) + cw[3][1] * bf_hi(pwin[t + 3]);
                xs[t][0] = silu_fast(y0); xs[t][1] = silu_fast(y1);
            }
            if (arr == 0) {
#pragma unroll
                for (int t = 0; t < 16; ++t) { *(LAS unsigned*)(Xb + (16 * tg + t) * LT + 2 * pr) = cvt_pk_bf16(xs[t][0], xs[t][1]);
                    *(LAS f32v2_t*)(Xs32 + (16 * tg + t) * 66 + 2 * pr) = (f32v2_t){xs[t][0], xs[t][1]}; }
            } else {
                LAS bf16_t* dst = (arr == 1) ? Bs : Cs;
#pragma unroll
                for (int t = 0; t < 16; ++t) *(LAS unsigned*)(dst + (16 * tg + t) * LT + 2 * pr) = cvt_pk_bf16(xs[t][0], xs[t][1]);
                if (arr == 1) {
#pragma unroll
                    for (int e = 0; e < 2; ++e) {
                        u32x4 p0, p1;
                        p0.x = cvt_pk_bf16(xs[0][e], xs[1][e]); p0.y = cvt_pk_bf16(xs[2][e], xs[3][e]); p0.z = cvt_pk_bf16(xs[4][e], xs[5][e]); p0.w = cvt_pk_bf16(xs[6][e], xs[7][e]);
                        p1.x = cvt_pk_bf16(xs[8][e], xs[9][e]); p1.y = cvt_pk_bf16(xs[10][e], xs[11][e]); p1.z = cvt_pk_bf16(xs[12][e], xs[13][e]); p1.w = cvt_pk_bf16(xs[14][e], xs[15][e]);
                        *(LAS u32x4*)(BTs + (2 * pr + e) * LT + 16 * tg) = p0; *(LAS u32x4*)(BTs + (2 * pr + e) * LT + 16 * tg + 8) = p1;
                    }
                }
            }
        } else if (w == 6) {
            const float dt = softplus_fast(bf1((bf16_t)pdr) + dtb);
            float cs = dt * aneg;
#pragma unroll
            for (int o = 1; o < 64; o <<= 1) { const float v = __shfl_up(cs, o); if (lane >= o) cs += v; }
            dts[lane] = dt; acs[lane] = cs;
            eacs[lane] = __expf(cs); wts[lane] = __expf(__shfl(cs, 63) - cs);
        }
        const u32x4 zb = *(const u32x4*)rpd;
        if (c + 1 < SEQ / 64) SSD_PREFETCH(c + 1);
        BAR_LDS();
        {
            const int pr2 = tid & 31, tgx = tid >> 5;
            float xd[4][2], xw[4][2];
#pragma unroll
            for (int t = 0; t < 4; ++t) { const int tk = 4 * tgx + t; const f32v2_t xv = *(const LAS f32v2_t*)(Xs32 + tk * 66 + 2 * pr2);
                const float d = dts[tk], wgt = wts[tk];
                xd[t][0] = xv[0] * d; xd[t][1] = xv[1] * d; xw[t][0] = xd[t][0] * wgt; xw[t][1] = xd[t][1] * wgt; }
#pragma unroll
            for (int e = 0; e < 2; ++e) {
                *(LAS u32x2*)(XTs + (2 * pr2 + e) * LT + 4 * tgx) = (u32x2){cvt_pk_bf16(xd[0][e], xd[1][e]), cvt_pk_bf16(xd[2][e], xd[3][e])};
                *(LAS u32x2*)(XWs + (2 * pr2 + e) * LT + 4 * tgx) = (u32x2){cvt_pk_bf16(xw[0][e], xw[1][e]), cvt_pk_bf16(xw[2][e], xw[3][e])};
            }
        }
        BAR_LDS();
        f32x16 yoff; ZERO16(yoff);
        const int tI = (w >> 1) & 1, tJ = w & 1;
        if (w < 4) {
            const int jt = tI, it = tJ;
            f32x16 sc; ZERO16(sc);
            if (it >= jt) sc = mma_nt(Bs, LT, 32 * jt, Cs, LT, 32 * it, 64, sc, lane);
            const int i = 32 * it + r32; const float ai = acs[i];
#pragma unroll
            for (int g = 0; g < 4; ++g) {
                const int j0 = 32 * jt + 8 * g + 4 * hh; const f32x4 aj = *(const LAS f32x4*)(acs + j0);
                float p[4];
#pragma unroll
                for (int j = 0; j < 4; ++j) p[j] = (i >= j0 + j) ? sc[4 * g + j] * __expf(ai - aj[j]) : 0.f;
                *(LAS u32x2*)(Ps + i * LT + j0) = (u32x2){cvt_pk_bf16(p[0], p[1]), cvt_pk_bf16(p[2], p[3])};
            }
        } else {
            yoff = mma_nt(Cs, LT, 32 * tI, Ss, LT, 32 * tJ, 64, yoff, lane);
        }
        BAR_LDS();
        if (w >= 4) {
            f32x16 yd; ZERO16(yd);
            yd = mma_nt(Ps, LT, 32 * tI, XTs, LT, 32 * tJ, 64, yd, lane);
#pragma unroll
            for (int rg = 0; rg < 16; ++rg) { const int i = 32 * tI + crow(rg, hh); Os[i * 68 + 32 * tJ + r32] = yd[rg] + eacs[i] * yoff[rg]; }
        } else {
            f32x16 tmp; ZERO16(tmp);
            tmp = mma_nt(BTs, LT, 32 * tI, XWs, LT, 32 * tJ, 64, tmp, lane);
            const float dec = eacs[63];
#pragma unroll
            for (int rg = 0; rg < 16; ++rg) S[rg] = dec * S[rg] + tmp[rg];
#pragma unroll
            for (int g = 0; g < 4; ++g)
                *(LAS u32x2*)(Ss + (32 * tJ + r32) * LT + 32 * tI + 8 * g + 4 * hh) = (u32x2){cvt_pk_bf16(S[4 * g], S[4 * g + 1]), cvt_pk_bf16(S[4 * g + 2], S[4 * g + 3])};
        }
        BAR_LDS();
        {
            const int i = tid >> 3, e8 = tid & 7;
            const LAS f32x4* op = (const LAS f32x4*)(Os + i * 68 + 8 * e8);
            const f32x4 o0 = op[0], o1 = op[1];
            const u32x4 xb = *(const LAS u32x4*)(Xb + i * LT + 8 * e8);
            float y[8];
            y[0] = (o0[0] + dsk * bf_lo(xb.x)) * bf_lo(zb.x); y[1] = (o0[1] + dsk * bf_hi(xb.x)) * bf_hi(zb.x);
            y[2] = (o0[2] + dsk * bf_lo(xb.y)) * bf_lo(zb.y); y[3] = (o0[3] + dsk * bf_hi(xb.y)) * bf_hi(zb.y);
            y[4] = (o1[0] + dsk * bf_lo(xb.z)) * bf_lo(zb.z); y[5] = (o1[1] + dsk * bf_hi(xb.z)) * bf_hi(zb.z);
            y[6] = (o1[2] + dsk * bf_lo(xb.w)) * bf_lo(zb.w); y[7] = (o1[3] + dsk * bf_hi(xb.w)) * bf_hi(zb.w);
            float ssq = 0.f;
#pragma unroll
            for (int j = 0; j < 8; ++j) ssq += y[j] * y[j];
            ssq += __shfl_xor(ssq, 1); ssq += __shfl_xor(ssq, 2); ssq += __shfl_xor(ssq, 4);
            if (e8 == 0) ssd[(row0 + i) * 8 + hd] = ssq;
            *(u32x4*)rpd = (u32x4){cvt_pk_bf16(y[0], y[1]), cvt_pk_bf16(y[2], y[3]), cvt_pk_bf16(y[4], y[5]), cvt_pk_bf16(y[6], y[7])};
        }
        BAR_LDS();
    }
#undef SSD_PREFETCH
}

DI void mixer_lru(const Ctx& a, LAS unsigned char* lds, int l, int b, int kb) {
    constexpr int LT = 72, LF = 68;
    int tid_ = threadIdx.x; asm volatile("" : "+v"(tid_));
    const int tid = tid_, lane = tid & 63, w = __builtin_amdgcn_readfirstlane(tid >> 6), r32 = lane & 31, hh = lane >> 5;
    bf16_t* proj = (bf16_t*)(a.ws + OFF_PROJ);
    LAS bf16_t* Us = (LAS bf16_t*)lds;
    LAS bf16_t* WTs = Us + 64 * LT;
    LAS float* U32 = (LAS float*)(WTs + 2 * 64 * LT);
    LAS float* As = U32 + 64 * LF;
    LAS float* Ms = As + 64 * LF;
    LAS float* Gs = Ms + 64 * LF;
    LAS float* GA = Gs + 64 * LF;
    LAS float* GH = GA + 8 * 64;
    for (int i = tid; i < 2 * 64 * 64; i += 512) { const int mat = i >> 12, d = (i >> 6) & 63, e = i & 63;
        const float v = (mat ? a.in(I_LWX) : a.in(I_LWA))[(((size_t)l * 8 + kb) * 64 + d) * 64 + e];
        WTs[(mat * 64 + e) * LT + d] = f2bf(v); }
    const int pr = tid & 31, tg = tid >> 5, ch = kb * 64 + 2 * pr;
    float cw[4][2], cb[2];
#pragma unroll
    for (int k = 0; k < 4; ++k) { cw[k][0] = a.in(I_LCW)[((size_t)l * 4 + k) * 512 + ch]; cw[k][1] = a.in(I_LCW)[((size_t)l * 4 + k) * 512 + ch + 1]; }
    cb[0] = a.in(I_LCB)[l * 512 + ch]; cb[1] = a.in(I_LCB)[l * 512 + ch + 1];
    const int mat = w >> 2, tm = (w >> 1) & 1, tn = w & 1, eg = kb * 64 + 32 * tn + r32;
    const float gbias = (mat ? a.in(I_LBX) : a.in(I_LBA))[l * 512 + eg];
    const float spl = -8.f * softplusf_(-a.in(I_LLAM)[l * 512 + eg]);
    float hstate = 0.f;
    const size_t rowb = (size_t)b * SEQ;
    unsigned pwin[7];
#define LRU_PREFETCH(cn) do { _Pragma("unroll") for (int t = 0; t < 7; ++t) { const int tt = 64 * (cn) + 4 * tg + t - 3; \
        pwin[t] = (tt >= 0) ? *(const unsigned*)(proj + (rowb + tt) * PLD + C_LX + ch) : 0u; } } while (0)
    LRU_PREFETCH(0);
    __syncthreads();
    for (int c = 0; c < SEQ / 64; ++c) {
        const size_t row0 = rowb + 64 * c;
        bf16_t* gp0 = proj + (row0 + 8 * w) * PLD + C_LG + kb * 64 + lane;
        {
#pragma unroll
            for (int t = 0; t < 4; ++t) {
                const float u0 = cb[0] + cw[0][0] * bf_lo(pwin[t]) + cw[1][0] * bf_lo(pwin[t + 1]) + cw[2][0] * bf_lo(pwin[t + 2]) + cw[3][0] * bf_lo(pwin[t + 3]);
                const float u1 = cb[1] + cw[0][1] * bf_hi(pwin[t]) + cw[1][1] * bf_hi(pwin[t + 1]) + cw[2][1] * bf_hi(pwin[t + 2]) + cw[3][1] * bf_hi(pwin[t + 3]);
                *(LAS unsigned*)(Us + (4 * tg + t) * LT + 2 * pr) = cvt_pk_bf16(u0, u1);
                U32[(4 * tg + t) * LF + 2 * pr] = u0; U32[(4 * tg + t) * LF + 2 * pr + 1] = u1;
            }
        }
        bf16_t pgt[8];
#pragma unroll
        for (int t = 0; t < 8; ++t) pgt[t] = gp0[(size_t)t * PLD];
        if (c + 1 < SEQ / 64) LRU_PREFETCH(c + 1);
        BAR_LDS();
        {
            f32x16 pre; ZERO16(pre);
            pre = mma_nt(Us, LT, 32 * tm, WTs + mat * 64 * LT, LT, 32 * tn, 64, pre, lane);
            const int e = 32 * tn + r32;
#pragma unroll
            for (int rg = 0; rg < 16; ++rg) {
                const int t = 32 * tm + crow(rg, hh);
                const float sg = sigmoid_fast(pre[rg] + gbias);
                if (mat == 0) { const float la = spl * sg; As[t * LF + e] = __expf(la); Ms[t * LF + e] = __builtin_amdgcn_sqrtf(fmaxf(1.f - __expf(2.f * la), 0.f)); }
                else Gs[t * LF + e] = sg * U32[t * LF + e];
            }
        }
        BAR_LDS();
        float hl[8], ap[8];
        {
            float hloc = 0.f, apr = 1.f;
#pragma unroll
            for (int t = 0; t < 8; ++t) { const int tt = 8 * w + t; const float av = As[tt * LF + lane], bv = Ms[tt * LF + lane] * Gs[tt * LF + lane];
                hloc = av * hloc + bv; apr *= av; hl[t] = hloc; ap[t] = apr; }
            GA[w * 64 + lane] = apr; GH[w * 64 + lane] = hloc;
        }
        BAR_LDS();
        {
            float carry = hstate, cin = hstate;
#pragma unroll
            for (int ww = 0; ww < 8; ++ww) { carry = GA[ww * 64 + lane] * carry + GH[ww * 64 + lane]; if (ww + 1 == w) cin = carry; }
            if (w == 0) cin = hstate;
            hstate = carry;
#pragma unroll
            for (int t = 0; t < 8; ++t) {
                const float ge = bf1(pgt[t]);
                gp0[(size_t)t * PLD] = f2bf((hl[t] + ap[t] * cin) * ge);
            }
        }
    }
#undef LRU_PREFETCH
    __syncthreads();
}

DI void phase_mixers(const Ctx& a, LAS unsigned char* lds, int l, int G) {
    const int it = blockIdx.x;
    const int mb = it & 7, mk = it >> 3;
    if (mk < 4) mixer_gla<128, true>(a, lds, l, mb, mk);
    else if (mk < 8) mixer_gla<64, false>(a, lds, l, mb, mk - 4);
    else if (mk < 16) mixer_ssd(a, lds, l, mb, mk - 8);
    else if (mk < 24) mixer_lru(a, lds, l, mb, mk - 16);
    if (l == 0) {
        __syncthreads();
        int tid_ = threadIdx.x; asm volatile("" : "+v"(tid_));
        convert_weights<true>(a, lds, tid_, WT_MIX, DEPTH * WT_PER_L, 0, (unsigned*)(a.ws + OFF_BAR) + WQ_WORD);
    }
}


#define XB_TMO      128
#define XB_XCNT(j)  (256  + 64 * (j))
#define XB_XSUB(j)  (1280 + 64 * (j))
#define XB_XGEN(j)  (2304 + 64 * (j))
#define XB_TOP      3328
#define XB_TOPGEN   3392
#define XCD_BAR_WORDS 3456
#define XB_SPIN_CAP (1u << 18)
DI unsigned xb_ld(unsigned* p)              { return __hip_atomic_load(p, __ATOMIC_RELAXED, __HIP_MEMORY_SCOPE_AGENT); }
DI unsigned xb_add(unsigned* p, unsigned v) { return __hip_atomic_fetch_add(p, v, __ATOMIC_RELAXED, __HIP_MEMORY_SCOPE_AGENT); }
DI unsigned xb_xcc_id() { return (unsigned)__builtin_amdgcn_s_getreg((3 << 11) | 20) & 0xFu; }
#define XB_SPIN(cond, bar) do { unsigned _sp = 0; while (cond) { __builtin_amdgcn_s_sleep(1); \
    if ((++_sp & 255u) == 0u) { if (xb_ld(&(bar)[XB_TMO])) break; if (_sp > XB_SPIN_CAP) { atomicAdd(&(bar)[XB_TMO], 1u); break; } } } } while (0)
struct XcdBarrier { unsigned* bar; unsigned x; volatile LAS unsigned* st; };
DI XcdBarrier xcd_barrier_post(unsigned* bar, volatile LAS unsigned* st) {
    XcdBarrier b; b.bar = bar; b.x = xb_xcc_id(); b.st = st;
    if (threadIdx.x == 0) (void)xb_add(&bar[XB_XCNT(b.x)], 1u);
    return b;
}
DI void xcd_barrier_complete(unsigned* bar, unsigned x, unsigned& nloc, unsigned& nx) {
    const unsigned G = gridDim.x * gridDim.y * gridDim.z;
    unsigned sum, cnt, mine, sp = 0u;
    for (;;) {
        sum = 0u; cnt = 0u; mine = 0u;
#pragma unroll
        for (unsigned j = 0; j < 16; ++j) { const unsigned c = xb_ld(&bar[XB_XCNT(j)]); sum += c; cnt += (c > 0u) ? 1u : 0u; mine = (j == x) ? c : mine; }
        if (sum == G) break;
        __builtin_amdgcn_s_sleep(1);
        if ((++sp & 255u) == 0u) { if (xb_ld(&bar[XB_TMO])) break; if (sp > XB_SPIN_CAP) { atomicAdd(&bar[XB_TMO], 1u); break; } }
    }
    nloc = mine > 0u ? mine : 1u; nx = cnt > 0u ? cnt : 1u;
}
DI void xcd_barrier(const XcdBarrier& b) {
    asm volatile("s_waitcnt vmcnt(0)" ::: "memory");
    __syncthreads();
    if (threadIdx.x == 0) {
        unsigned* bar = b.bar;
        __builtin_amdgcn_s_waitcnt(0);
        unsigned nloc = b.st[0], nx = b.st[1];
        if (nloc == 0u) { xcd_barrier_complete(bar, b.x, nloc, nx); b.st[0] = nloc; b.st[1] = nx; }
        const unsigned old = xb_add(&bar[XB_XSUB(b.x)], 1u);
        const unsigned gen = old / nloc;
        if (old + 1u == (gen + 1u) * nloc) {
            __builtin_amdgcn_fence(__ATOMIC_RELEASE, "agent");
            asm volatile("s_waitcnt vmcnt(0)" ::: "memory");
            const unsigned og = xb_add(&bar[XB_TOP], 1u);
            const unsigned tg = og / nx;
            if (og + 1u == (tg + 1u) * nx) xb_add(&bar[XB_TOPGEN], 1u);
            else XB_SPIN(xb_ld(&bar[XB_TOPGEN]) == tg, bar);
            __builtin_amdgcn_fence(__ATOMIC_ACQUIRE, "agent");
            xb_add(&bar[XB_XGEN(b.x)], 1u);
            asm volatile("s_waitcnt vmcnt(0)" ::: "memory");
        } else {
            XB_SPIN(xb_ld(&bar[XB_XGEN(b.x)]) == gen, bar);
            __builtin_amdgcn_fence(__ATOMIC_ACQUIRE, "agent");
            asm volatile("s_waitcnt vmcnt(0)" ::: "memory");
        }
    }
    __syncthreads();
}

DI float ss_sum16(const float* p16) {
    const f32x4* p = (const f32x4*)p16; const f32x4 a = p[0], b = p[1], c = p[2], d = p[3];
    return (((a[0] + a[1]) + (a[2] + a[3])) + ((b[0] + b[1]) + (b[2] + b[3]))) + (((c[0] + c[1]) + (c[2] + c[3])) + ((d[0] + d[1]) + (d[2] + d[3])));
}
DI void ss_reduce_own(const float* ssp, float* ss, const pg8::StaticOrder& S) {
    pg8::Unit u; int prev = -1;
    for (int i = 0; S.next(i, u); ++i) {
        if (u.pm != prev) { prev = u.pm; if (threadIdx.x < 256) { const int row = u.pm * 256 + threadIdx.x; ss[row] = ss_sum16(ssp + (size_t)row * 16); } }
    }
    asm volatile("s_waitcnt vmcnt(0)" ::: "memory");
    __syncthreads();
}

__global__ void __launch_bounds__(512, 2) fwd(Args ka) {
    extern __shared__ __attribute__((aligned(16))) unsigned char lds_raw[];
    LAS unsigned char* lds = (LAS unsigned char*)lds_raw;
    if (threadIdx.x < 27) *(const float* LAS*)(lds + PTAB_OFF + 8 * threadIdx.x) = ka.in[threadIdx.x];
    if (threadIdx.x < 2) ((LAS unsigned*)(lds + XBST_OFF))[threadIdx.x] = 0u;
    __syncthreads();
    const XcdBarrier xb = xcd_barrier_post((unsigned*)(ka.ws + OFF_BAR), (volatile LAS unsigned*)(lds + XBST_OFF));
    Ctx a; a.lds = lds; a.out = ka.out; a.ws = ka.ws;
    cg::grid_group grid = cg::this_grid();
    const int G = gridDim.x, bid = blockIdx.x;
    unsigned char* ws = a.ws;
    bf16_t* proj = (bf16_t*)(ws + OFF_PROJ);
    bf16_t* hbf = (bf16_t*)(ws + OFF_HBF);
    float* ss = (float*)(ws + OFF_SS);
    float* ssd = (float*)(ws + OFF_SSD);
    float* ssp = (float*)(ws + OFF_SSP);

    phase_prologue(a, lds, G);
    if (ka.pad != 0) grid.sync();
    xcd_barrier(xb);

#pragma unroll 1
    for (int l = 0; l < DEPTH; ++l) {
        unsigned char* wl = ws + OFF_W + (size_t)l * W_LAYER;
        float* ss_mix = ss; float* ss_ffn = ss + MT;
        {
            pg8::Gemm g{hbf, (const bf16_t*)(wl + WO_MIX), MT, NMIX, DM, DM, DM}; pg8::StaticOrder S; S.init(MT, NMIX, G, bid);
            if (l > 0) ss_reduce_own(ssp, ss_mix, S);
            pg8::EpiScale<2> E{proj, PLD, ss_mix};
            pg8::gemm_phase(lds, g, S, E);
        }
        xcd_barrier(xb);
        phase_mixers(a, lds, l, G);
        xcd_barrier(xb);
        {
            pg8::StaticOrder S; S.init(MT, DM, G, bid);
            {
                pg8::GateOrder GS{S};
                pg8::Gemm g{hbf, (const bf16_t*)(wl + WO_GATE), MT, 4 * DM, DM, DM, DM};
                pg8::EpiScale<1> E{proj + C_GATES, PLD, ss_mix};
                pg8::gemm_phase(lds, g, GS, E);
            }
            {
                pg8::BranchOrder BS{S};
                pg8::Gemm g{proj, (const bf16_t*)(wl + WO_BR), MT, DM, 512, PLD, 512};
                pg8::EpiBranch E{proj + C_GATES, proj + C_MRG16, PLD, ssd};
                pg8::gemm_phase(lds, g, BS, E);
            }
        }
        xcd_barrier(xb);
        {
            pg8::Gemm g{proj + C_MRG16, (const bf16_t*)(wl + WO_OUT), MT, DM, DM, PLD, DM}; pg8::StaticOrder S; S.init(MT, DM, G, bid);
            pg8::EpiResid E{(l == 0) ? a.in(I_X) : (const float*)nullptr, nullptr, hbf, ssp};
            pg8::gemm_phase(lds, g, S, E);
        }
        xcd_barrier(xb);
        {
            pg8::Gemm g{hbf, (const bf16_t*)(wl + WO_FIN), MT, 2 * DFF, DM, DM, DM}; pg8::StaticOrder S; S.init(MT, 2 * DFF, G, bid);
            ss_reduce_own(ssp, ss_ffn, S);
            pg8::EpiSwiglu E{proj, PLD, ss_ffn};
            pg8::gemm_phase(lds, g, S, E);
        }
        xcd_barrier(xb);
        {
            pg8::Gemm g{proj, (const bf16_t*)(wl + WO_FOUT), MT, DM, DFF, PLD, DFF}; pg8::StaticOrder S; S.init(MT, DM, G, bid);
            pg8::EpiResid E{nullptr, nullptr, hbf, ssp};
            pg8::gemm_phase(lds, g, S, E);
        }
        xcd_barrier(xb);
    }
    {
        int tid_ = threadIdx.x; asm volatile("" : "+v"(tid_));
        const int tid = tid_, lane = tid & 63, wave = tid >> 6;
        const f32x4* nf = (const f32x4*)a.in(I_NF);
        const f32x4 n0 = nf[2 * lane], n1 = nf[2 * lane + 1], n2 = nf[2 * (lane + 64)], n3 = nf[2 * (lane + 64) + 1];
        for (int m0 = 4 * (bid * 8 + wave); m0 < MT; m0 += 4 * G * 8) {
            u32x4 w0[4], w1[4]; float sq[4];
#pragma unroll
            for (int r = 0; r < 4; ++r) { const u32x4* hrow = (const u32x4*)(hbf + (size_t)(m0 + r) * DM); w0[r] = hrow[lane]; w1[r] = hrow[lane + 64]; sq[r] = ss_sum16(ssp + (size_t)(m0 + r) * 16); }
#pragma unroll
            for (int r = 0; r < 4; ++r) {
                const float rs = rsqrtf(sq[r] * (1.0f / DM) + EPS);
                f32x4* orow = (f32x4*)(a.out + (size_t)(m0 + r) * DM);
                orow[2 * lane] = (f32x4){bf_lo(w0[r].x), bf_hi(w0[r].x), bf_lo(w0[r].y), bf_hi(w0[r].y)} * rs * n0;
                orow[2 * lane + 1] = (f32x4){bf_lo(w0[r].z), bf_hi(w0[r].z), bf_lo(w0[r].w), bf_hi(w0[r].w)} * rs * n1;
                orow[2 * (lane + 64)] = (f32x4){bf_lo(w1[r].x), bf_hi(w1[r].x), bf_lo(w1[r].y), bf_hi(w1[r].y)} * rs * n2;
                orow[2 * (lane + 64) + 1] = (f32x4){bf_lo(w1[r].z), bf_hi(w1[r].z), bf_lo(w1[r].w), bf_hi(w1[r].w)} * rs * n3;
            }
        }
    }
}

extern "C" void kernel_launch(void* const* d_in, const int* in_sizes, int n_in, void* d_out, int out_size, void* d_ws, size_t ws_size, hipStream_t stream) {
    static int grid = 0;
    if (grid == 0) {
        if (n_in != 27 || out_size != MT * DM || ws_size < WS_NEED) { fprintf(stderr, "kernel_launch: unexpected shapes (n_in %d out %d ws %zu need %zu)\n", n_in, out_size, ws_size, (size_t)WS_NEED); grid = -1; return; }
        int dev = 0, cus = 0, per_cu = 0;
        (void)hipGetDevice(&dev);
        (void)hipDeviceGetAttribute(&cus, hipDeviceAttributeMultiprocessorCount, dev);
        (void)hipFuncSetAttribute((const void*)fwd, hipFuncAttributeMaxDynamicSharedMemorySize, LDS_BYTES);
        (void)hipOccupancyMaxActiveBlocksPerMultiprocessor(&per_cu, (const void*)fwd, 512, LDS_BYTES);
        if (per_cu < 1) per_cu = 1;
        if (per_cu > 1) per_cu = 1;
        grid = cus * per_cu;
        if (grid < 192) { fprintf(stderr, "kernel_launch: needs >= 192 resident workgroups, got %d\n", grid); grid = -1; return; }
    }
    if (grid < 0) return;
    (void)hipMemsetAsync((unsigned char*)d_ws + OFF_BAR, 0, SZ_BAR, stream);
    Args a{};
    for (int i = 0; i < 27; ++i) a.in[i] = (const float*)d_in[i];
    a.out = (float*)d_out; a.ws = (unsigned char*)d_ws; a.pad = 0;
    void* args[] = {&a};
    hipError_t e = hipLaunchCooperativeKernel((const void*)fwd, dim3(grid), dim3(512), args, LDS_BYTES, stream);
    if (e != hipSuccess) fprintf(stderr, "cooperative launch failed: %s (grid %d)\n", hipGetErrorString(e), grid);
}
```
